# Optimizing an MI355X kernel written in HIP

```python
import math
import jax, jax.numpy as jnp
from jax import lax
import numpy as np

D_MODEL = 1024
BATCH = 16
SEQ = 4096
DEPTH = 1

CHUNK = 64
N_LEFT_CHUNKS = 8
BAND = N_LEFT_CHUNKS + 1
ATT_HEADS = 8
HEAD_DIM = 64
ATT_WIDTH = ATT_HEADS * HEAD_DIM
REL_CLIP = 128
SSM_WIDTH = D_MODEL // 2
SSM_GROUP = 16
SSM_GROUPS = SSM_WIDTH // SSM_GROUP
SSM_STATE = 64
N_BRANCH = 2
IN_WIDTH = 3 * ATT_WIDTH + SSM_WIDTH + N_BRANCH * D_MODEL
D_FF = 4 * D_MODEL
EPS = 1e-6
DT_MIN = 1e-3
DT_MAX = 1e-1
NEG_INF = -1e30

kernel_name = 'chunk_causal_attn_s5_gated_hybrid'


def rms_norm(x, g):
    xf = x.astype(jnp.float32)
    y = xf * lax.rsqrt(jnp.mean(xf * xf, axis=-1, keepdims=True) + EPS)
    return (y * g.astype(jnp.float32)).astype(x.dtype)


def chunked_band_attention(q, k, v, rel_bias):
    b, s, h, dh = q.shape
    nc = s // CHUNK
    pad = N_LEFT_CHUNKS * CHUNK
    qc = q.reshape(b, nc, CHUNK, h, dh)
    kp = jnp.pad(k, ((0, 0), (pad, 0), (0, 0), (0, 0))).reshape(b, nc + N_LEFT_CHUNKS, CHUNK, h, dh)
    vp = jnp.pad(v, ((0, 0), (pad, 0), (0, 0), (0, 0))).reshape(b, nc + N_LEFT_CHUNKS, CHUNK, h, dh)
    w = jnp.arange(BAND)
    band_idx = jnp.arange(nc)[:, None] + w[None, :]
    kb = kp[:, band_idx]
    vb = vp[:, band_idx]
    scores = jnp.einsum('bnchd,bnwjhd->bnhcwj', qc, kb).astype(jnp.float32) * (dh ** -0.5)
    c = jnp.arange(CHUNK)
    dist = (BAND - 1 - w)[None, :, None] * CHUNK + c[:, None, None] - c[None, None, :]
    bias = rel_bias.astype(jnp.float32)[:, jnp.clip(dist, -REL_CLIP, REL_CLIP) + REL_CLIP]
    valid = (jnp.arange(nc)[:, None] - N_LEFT_CHUNKS + w[None, :]) >= 0
    scores = jnp.where(valid[None, :, None, None, :, None], scores + bias[None, None], NEG_INF)
    probs = jax.nn.softmax(scores.reshape(b, nc, h, CHUNK, BAND * CHUNK), axis=-1)
    probs = probs.reshape(b, nc, h, CHUNK, BAND, CHUNK).astype(v.dtype)
    out = jnp.einsum('bnhcwj,bnwjhd->bnchd', probs, vb)
    return out.reshape(b, s, h * dh)


def s5_ssm(u, a_re, a_im, log_dt, b_re, b_im, c_re, c_im, d_skip):
    f32 = jnp.float32
    b, s, _ = u.shape
    uf = u.astype(f32).reshape(b, s, SSM_GROUPS, SSM_GROUP)
    lam = lax.complex(a_re.astype(f32), a_im.astype(f32))
    dt = jnp.exp(log_dt.astype(f32))[:, None]
    lam_bar = jnp.exp(lam * dt)
    b_bar = ((lam_bar - 1.0) / lam)[..., None] * lax.complex(b_re.astype(f32), b_im.astype(f32))
    bu = jnp.einsum('gph,bsgh->bsgp', b_bar, uf.astype(jnp.complex64))
    a_seq = jnp.broadcast_to(lam_bar, bu.shape)

    def combine(e1, e2):
        a1, x1 = e1
        a2, x2 = e2
        return a1 * a2, a2 * x1 + x2

    _, states = lax.associative_scan(combine, (a_seq, bu), axis=1)
    c_mat = lax.complex(c_re.astype(f32), c_im.astype(f32))
    y = jnp.einsum('ghp,bsgp->bsgh', c_mat, states).real + d_skip.astype(f32) * uf
    return y.reshape(b, s, SSM_WIDTH).astype(u.dtype)


def mixer_block(h, norm_g, w_in, b_gate, rel_bias, a_re, a_im, log_dt, b_re, b_im, c_re, c_im,
                d_skip, w_glu, w_proj_a, w_proj_b, w_out):
    b, s, _ = h.shape
    u = rms_norm(h, norm_g)
    z = u @ w_in
    q, k, v, us, zg = jnp.split(
        z, [ATT_WIDTH, 2 * ATT_WIDTH, 3 * ATT_WIDTH, 3 * ATT_WIDTH + SSM_WIDTH], axis=-1)
    heads = (b, s, ATT_HEADS, HEAD_DIM)
    att = chunked_band_attention(q.reshape(heads), k.reshape(heads), v.reshape(heads), rel_bias)
    y_a = att @ w_proj_a
    ys = jax.nn.gelu(s5_ssm(us, a_re, a_im, log_dt, b_re, b_im, c_re, c_im, d_skip))
    glu_v, glu_g = jnp.split(ys @ w_glu, 2, axis=-1)
    y_b = (glu_v * jax.nn.sigmoid(glu_g)) @ w_proj_b
    gates = jax.nn.sigmoid(zg + b_gate).reshape(b, s, N_BRANCH, D_MODEL)
    mixed = gates[:, :, 0] * y_a + gates[:, :, 1] * y_b
    return mixed @ w_out


def setup_inputs(seed: int = 0) -> dict:
    key = jax.random.key(seed)
    ks = jax.random.split(key, 24)
    L, G, P, Hg = DEPTH, SSM_GROUPS, SSM_STATE, SSM_GROUP
    nrm = lambda k, shape, scale: jax.random.normal(k, shape, jnp.float32) * scale
    x = jax.random.normal(ks[0], (BATCH, SEQ, D_MODEL), jnp.float32)
    norm_mix = 1.0 + nrm(ks[1], (L, D_MODEL), 0.01)
    w_in = nrm(ks[2], (L, D_MODEL, IN_WIDTH), D_MODEL ** -0.5)
    b_gate = nrm(ks[3], (L, N_BRANCH * D_MODEL), 0.01)
    rel_bias = nrm(ks[4], (L, ATT_HEADS, 2 * REL_CLIP + 1), 0.5)
    ssm_a_re = -0.5 * jnp.exp(nrm(ks[5], (L, G, P), 0.01))
    ssm_a_im = math.pi * jnp.arange(P, dtype=jnp.float32)[None, None, :] * (1.0 + nrm(ks[6], (L, G, P), 0.01))
    ssm_log_dt = jax.random.uniform(ks[7], (L, G), jnp.float32, math.log(DT_MIN), math.log(DT_MAX))
    ssm_b_re = nrm(ks[8], (L, G, P, Hg), (2.0 * Hg) ** -0.5)
    ssm_b_im = nrm(ks[9], (L, G, P, Hg), (2.0 * Hg) ** -0.5)
    ssm_c_re = nrm(ks[10], (L, G, Hg, P), (2.0 * P) ** -0.5)
    ssm_c_im = nrm(ks[11], (L, G, Hg, P), (2.0 * P) ** -0.5)
    ssm_d = nrm(ks[12], (L, G, Hg), 1.0)
    w_glu = nrm(ks[13], (L, SSM_WIDTH, 2 * SSM_WIDTH), SSM_WIDTH ** -0.5)
    w_proj_a = nrm(ks[14], (L, ATT_WIDTH, D_MODEL), ATT_WIDTH ** -0.5)
    w_proj_b = nrm(ks[15], (L, SSM_WIDTH, D_MODEL), SSM_WIDTH ** -0.5)
    w_out = nrm(ks[16], (L, D_MODEL, D_MODEL), D_MODEL ** -0.5)
    norm_ffn = 1.0 + nrm(ks[17], (L, D_MODEL), 0.01)
    w_ff1 = nrm(ks[18], (L, D_MODEL, D_FF), D_MODEL ** -0.5)
    w_ff2 = nrm(ks[19], (L, D_FF, D_MODEL), D_FF ** -0.5)
    norm_final = 1.0 + nrm(ks[20], (D_MODEL,), 0.01)
    return {'x': x, 'norm_mix': norm_mix, 'w_in': w_in, 'b_gate': b_gate, 'rel_bias': rel_bias,
            'ssm_a_re': ssm_a_re, 'ssm_a_im': ssm_a_im, 'ssm_log_dt': ssm_log_dt,
            'ssm_b_re': ssm_b_re, 'ssm_b_im': ssm_b_im, 'ssm_c_re': ssm_c_re, 'ssm_c_im': ssm_c_im,
            'ssm_d': ssm_d, 'w_glu': w_glu, 'w_proj_a': w_proj_a, 'w_proj_b': w_proj_b,
            'w_out': w_out, 'norm_ffn': norm_ffn, 'w_ff1': w_ff1, 'w_ff2': w_ff2,
            'norm_final': norm_final}


def reference(x, norm_mix, w_in, b_gate, rel_bias, ssm_a_re, ssm_a_im, ssm_log_dt,
              ssm_b_re, ssm_b_im, ssm_c_re, ssm_c_im, ssm_d, w_glu, w_proj_a, w_proj_b,
              w_out, norm_ffn, w_ff1, w_ff2, norm_final):
    h = x
    for l in range(DEPTH):
        h = h + mixer_block(h, norm_mix[l], w_in[l], b_gate[l], rel_bias[l], ssm_a_re[l], ssm_a_im[l],
                            ssm_log_dt[l], ssm_b_re[l], ssm_b_im[l], ssm_c_re[l], ssm_c_im[l],
                            ssm_d[l], w_glu[l], w_proj_a[l], w_proj_b[l], w_out[l])
        f = rms_norm(h, norm_ffn[l]) @ w_ff1[l]
        h = h + jnp.square(jax.nn.relu(f)) @ w_ff2[l]
    return rms_norm(h, norm_final)
```

```cpp
#include <hip/hip_runtime.h>
#include <hip/hip_cooperative_groups.h>
#include <cstdio>
#include <cstdint>
namespace cg = cooperative_groups;
#ifndef ONE_LAUNCH
#define ONE_LAUNCH 1
#endif
#define DI __device__ __forceinline__
typedef float f32x2 __attribute__((ext_vector_type(2)));
typedef float f32x16 __attribute__((ext_vector_type(16)));
typedef unsigned u32x2 __attribute__((ext_vector_type(2)));
typedef short s16x4 __attribute__((ext_vector_type(4)));
typedef __bf16 bf2_t __attribute__((ext_vector_type(2)));
DI unsigned pkbf(float lo, float hi) { f32x2 v = {lo, hi}; return __builtin_bit_cast(unsigned, __builtin_convertvector(v, bf2_t)); }
DI float bf_lo(unsigned w) { return __uint_as_float(w << 16); }
DI float bf_hi(unsigned w) { return __uint_as_float(w & 0xffff0000u); }
DI float sigmoid_f(float x) { return __builtin_amdgcn_rcpf(1.0f + __expf(-x)); }
DI unsigned pk4u8(float a, float b, float c, float d) { return (unsigned)(a * 255.0f + 0.5f) | ((unsigned)(b * 255.0f + 0.5f) << 8) | ((unsigned)(c * 255.0f + 0.5f) << 16) | ((unsigned)(d * 255.0f + 0.5f) << 24); }
DI float u8f(unsigned w, int e) { return (float)((w >> (8 * e)) & 0xffu); }
namespace pg8 {
#define PG8_LAS __attribute__((address_space(3)))
typedef unsigned short bf16_t;
typedef short bf16x8 __attribute__((ext_vector_type(8)));
typedef float f32x4 __attribute__((ext_vector_type(4)));
typedef unsigned u32x4 __attribute__((ext_vector_type(4)));
constexpr int BM = 256, BK = 64, HALF = 128, HTB = HALF * BK * 2  , STAGE_BYTES = 8 * HTB, NXCD = 8, WGM = 8;

__host__ __device__ __forceinline__ int lds_byte(int r, int c) { const int st = (r >> 4) * 2 + (c >> 5), rr = r & 15, cc = c & 31, ob = rr * 64 + cc * 2; return st * 1024 + (ob ^ (((ob >> 9) & 1) << 5)); }
__host__ __device__ __forceinline__ void stage_rc(int b, int& R, int& C) { const int st = b / 1024, sb = b % 1024, swz = sb ^ (((sb >> 9) & 1) << 5); R = (st >> 1) * 16 + swz / 64; C = (st & 1) * 32 + (swz % 64) / 2; }
__host__ __device__ __forceinline__ int perm32(int rho) { const int n = rho >> 4, i = rho & 15; return 8 * (i >> 2) + 4 * n + (i & 3); }

struct Unit { int pm, pn, seg; };
struct Gemm { const bf16_t* A; const bf16_t* Bt; int K, lda, ldb, btile; };

struct StaticOrder {
    int nM, nN, nwg, G, c;
    __host__ __device__ void init(int M, int N, int G_, int c_) { nM = M / BM; nN = N / BM; nwg = nM * nN; G = G_; c = c_; }
    __host__ __device__ bool next(int i, Unit& u) const {
        const long L = (long)i * G + c; if (L >= nwg) return false;
        int wgid = (int)L; { const int q = nwg / NXCD, r = nwg % NXCD, xcd = wgid % NXCD, off = wgid / NXCD; wgid = (xcd < r ? xcd * (q + 1) : r * (q + 1) + (xcd - r) * q) + off; }
        const int nig = WGM * nN, gid = wgid / nig, fm = gid * WGM, gsz = (nM - fm) < WGM ? (nM - fm) : WGM;
        u.pm = fm + ((wgid % nig) % gsz); u.pn = (wgid % nig) / gsz; return true;
    }
    __device__ __forceinline__ int kt(const Unit&, int ntf) const { return ntf; }
    __device__ __forceinline__ size_t koff(const Unit&) const { return 0; }
    __device__ __forceinline__ void a_ready(const Unit&) const {}
    __device__ __forceinline__ void done(const Unit&) const {}
};

template <class Epi, class Sched, bool ALIGN_EPI = false, bool SP2 = false>
__device__ __forceinline__ void gemm_phase(PG8_LAS unsigned char* lds, const Gemm g, const Sched& S, const Epi& E) {
    const int tid = threadIdx.x, wid = __builtin_amdgcn_readfirstlane(tid >> 6), lane = tid & 63, wr = wid >> 2, wc = wid & 3, fr = lane & 15, fq = lane >> 4;
    const int ntf = g.K / BK;
    unsigned voffA[2], voffB[2];
#pragma unroll
    for (int i = 0; i < 2; ++i) { int R, C; stage_rc(tid * 16 + i * 8192, R, C); const int Rb = Epi::PERM ? ((R & ~31) + perm32(R & 31)) : R;
        voffA[i] = (unsigned)(R * g.lda + C) * 2u; voffB[i] = (unsigned)(Rb * g.ldb + C) * 2u; }
    const size_t kstep = (size_t)(BK * 2);
    const size_t hstepA = (size_t)HALF * g.lda * 2, hstepB = (size_t)HALF * g.ldb * 2;
    const size_t tstepA = 2 * hstepA, tstepB = (size_t)g.btile * g.ldb * 2;
    const unsigned ldsw = (unsigned)wid * 1024u;
    const int aoff = lds_byte(wr * 64 + fr, fq * 8), boff = lds_byte(wc * 32 + fr, fq * 8);
#define PG8_SA(b, h) (((b) * 2 + (h)) * HTB)
#define PG8_SB(b, h) ((4 + (b) * 2 + (h)) * HTB)
#define PG8_STAGE(bufoff, gbase, voff) do { _Pragma("unroll") for (int _i = 0; _i < 2; ++_i) \
        __builtin_amdgcn_global_load_lds((const unsigned*)((const char*)(gbase) + (voff)[_i]), (PG8_LAS unsigned*)(lds + (bufoff) + ldsw + _i * 8192), 16, 0, 0); } while (0)
#define PG8_LDA(dst, b, h) do { _Pragma("unroll") for (int m = 0; m < 4; ++m) _Pragma("unroll") for (int k = 0; k < 2; ++k) dst[m][k] = *(const PG8_LAS bf16x8*)(lds + PG8_SA(b, h) + aoff + m * 2048 + k * 1024); } while (0)
#define PG8_LDB(dst, b, h) do { _Pragma("unroll") for (int n = 0; n < 2; ++n) _Pragma("unroll") for (int k = 0; k < 2; ++k) dst[n][k] = *(const PG8_LAS bf16x8*)(lds + PG8_SB(b, h) + boff + n * 2048 + k * 1024); } while (0)
#define PG8_MMA(ai, bj, At, Bt) do { __builtin_amdgcn_s_setprio(1); _Pragma("unroll") for (int m = 0; m < 4; ++m) _Pragma("unroll") for (int n = 0; n < 2; ++n) _Pragma("unroll") for (int k = 0; k < 2; ++k) \
        acc[ai][bj][m][n] = __builtin_amdgcn_mfma_f32_16x16x32_bf16(Bt[n][k], At[m][k], acc[ai][bj][m][n], 0, 0, 0); __builtin_amdgcn_s_setprio(0); } while (0)
#define PG8_WAIT_V(n) asm volatile("s_waitcnt vmcnt(" #n ")" ::: "memory")
#define PG8_WAIT_L(n) asm volatile("s_waitcnt lgkmcnt(" #n ")" ::: "memory")
#define PG8_BAR __builtin_amdgcn_s_barrier()
#define PG8_SCHED __builtin_amdgcn_sched_barrier(0)
    Unit cur, nxt; int ui = 0;
    if (!S.next(0, cur)) return;
    f32x4 acc[2][2][4][2];
#pragma unroll
    for (int a = 0; a < 2; ++a)
#pragma unroll
        for (int b = 0; b < 2; ++b)
#pragma unroll
            for (int m = 0; m < 4; ++m)
#pragma unroll
                for (int n = 0; n < 2; ++n) acc[a][b][m][n] = (f32x4){0.f, 0.f, 0.f, 0.f};
    bf16x8 At[4][2], B0[2][2], B1[2][2];
    const char* cA = (const char*)g.A + (size_t)cur.pm * tstepA + S.koff(cur); const char* cB = (const char*)g.Bt + (size_t)cur.pn * tstepB + S.koff(cur);
    S.a_ready(cur);
    if constexpr (SP2) {
        PG8_STAGE(PG8_SB(0, 0), cB, voffB); PG8_STAGE(PG8_SB(0, 1), cB + hstepB, voffB); PG8_STAGE(PG8_SA(0, 0), cA, voffA); PG8_STAGE(PG8_SA(0, 1), cA + hstepA, voffA);
        if (wr == 1) PG8_BAR;
        PG8_WAIT_V(2); PG8_BAR;
        PG8_STAGE(PG8_SB(1, 0), cB + kstep, voffB); PG8_STAGE(PG8_SA(1, 0), cA + kstep, voffA); PG8_STAGE(PG8_SB(1, 1), cB + hstepB + kstep, voffB);
        PG8_WAIT_V(6); PG8_BAR;
    } else {
        PG8_STAGE(PG8_SB(0, 0), cB, voffB); PG8_STAGE(PG8_SA(0, 0), cA, voffA); PG8_STAGE(PG8_SB(0, 1), cB + hstepB, voffB); PG8_STAGE(PG8_SA(0, 1), cA + hstepA, voffA);
        if (wr == 1) PG8_BAR;
        PG8_WAIT_V(4); PG8_BAR;
        PG8_STAGE(PG8_SB(1, 0), cB + kstep, voffB); PG8_STAGE(PG8_SA(1, 0), cA + kstep, voffA); PG8_STAGE(PG8_SB(1, 1), cB + hstepB + kstep, voffB);
        PG8_WAIT_V(6); PG8_BAR;
    }
    for (;;) {
        const bool has_next = S.next(ui + 1, nxt);
        const char* nA = has_next ? (const char*)g.A + (size_t)nxt.pm * tstepA + S.koff(nxt) : cA; const char* nB = has_next ? (const char*)g.Bt + (size_t)nxt.pn * tstepB + S.koff(nxt) : cB;
        const int nt = S.kt(cur, ntf);
        for (int t = 0; t < nt; t += 2) {
            const bool last = (t == nt - 2);
            const char* a1 = cA + (size_t)(t + 1) * kstep;
            const char* a2 = last ? nA : cA + (size_t)(t + 2) * kstep; const char* b2 = last ? nB : cB + (size_t)(t + 2) * kstep;
            const char* a3 = a2 + kstep; const char* b3 = b2 + kstep;
            if (last && has_next) S.a_ready(nxt);
            if constexpr (SP2) {
            PG8_LDB(B0, 0, 0); PG8_LDB(B1, 0, 1); PG8_SCHED; PG8_LDA(At, 0, 0); PG8_STAGE(PG8_SA(1, 1), a1 + hstepA, voffA);
            PG8_WAIT_V(8); PG8_WAIT_L(0); PG8_BAR; PG8_MMA(0, 0, At, B0); PG8_MMA(0, 1, At, B1); PG8_BAR; PG8_SCHED;
            PG8_LDA(At, 0, 1); PG8_STAGE(PG8_SB(0, 0), b2, voffB); PG8_STAGE(PG8_SB(0, 1), b2 + hstepB, voffB); PG8_STAGE(PG8_SA(0, 0), a2, voffA);
            PG8_WAIT_V(8); PG8_WAIT_L(0); PG8_BAR; PG8_MMA(1, 0, At, B0); PG8_MMA(1, 1, At, B1); PG8_BAR; PG8_SCHED;
            PG8_LDB(B0, 1, 0); PG8_LDB(B1, 1, 1); PG8_SCHED; PG8_LDA(At, 1, 0); PG8_STAGE(PG8_SA(0, 1), a2 + hstepA, voffA);
            PG8_WAIT_V(8); PG8_WAIT_L(0); PG8_BAR; PG8_MMA(0, 0, At, B0); PG8_MMA(0, 1, At, B1); PG8_BAR; PG8_SCHED;
            PG8_LDA(At, 1, 1); PG8_STAGE(PG8_SB(1, 0), b3, voffB); PG8_STAGE(PG8_SB(1, 1), b3 + hstepB, voffB); PG8_STAGE(PG8_SA(1, 0), a3, voffA);
            PG8_WAIT_V(8); PG8_WAIT_L(0); PG8_BAR; PG8_MMA(1, 0, At, B0); PG8_MMA(1, 1, At, B1); PG8_BAR; PG8_SCHED;
            } else {
            PG8_LDB(B0, 0, 0); PG8_SCHED; PG8_LDA(At, 0, 0); PG8_STAGE(PG8_SA(1, 1), a1 + hstepA, voffA);
            PG8_WAIT_L(8); PG8_BAR; PG8_WAIT_L(0); PG8_MMA(0, 0, At, B0); PG8_BAR; PG8_SCHED;
            PG8_LDB(B1, 0, 1); PG8_STAGE(PG8_SB(0, 0), b2, voffB);
            PG8_BAR; PG8_WAIT_L(0); PG8_MMA(0, 1, At, B1); PG8_BAR;
            PG8_LDA(At, 0, 1); PG8_STAGE(PG8_SA(0, 0), a2, voffA);
            PG8_BAR; PG8_WAIT_L(0); PG8_MMA(1, 0, At, B0); PG8_BAR; PG8_SCHED;
            PG8_STAGE(PG8_SB(0, 1), b2 + hstepB, voffB);
            PG8_WAIT_V(6); PG8_BAR; PG8_MMA(1, 1, At, B1); PG8_BAR;
            PG8_LDB(B0, 1, 0); PG8_SCHED; PG8_LDA(At, 1, 0); PG8_STAGE(PG8_SA(0, 1), a2 + hstepA, voffA);
            PG8_WAIT_L(8); PG8_BAR; PG8_WAIT_L(0); PG8_MMA(0, 0, At, B0); PG8_BAR; PG8_SCHED;
            PG8_LDB(B1, 1, 1); PG8_STAGE(PG8_SB(1, 0), b3, voffB);
            PG8_BAR; PG8_WAIT_L(0); PG8_MMA(0, 1, At, B1); PG8_BAR;
            PG8_LDA(At, 1, 1); PG8_STAGE(PG8_SA(1, 0), a3, voffA);
            PG8_BAR; PG8_WAIT_L(0); PG8_MMA(1, 0, At, B0); PG8_BAR; PG8_SCHED;
            PG8_STAGE(PG8_SB(1, 1), b3 + hstepB, voffB);
            PG8_WAIT_V(6); PG8_BAR; PG8_MMA(1, 1, At, B1); PG8_BAR;
            }
        }
        if constexpr (ALIGN_EPI) { if (wr == 0) PG8_BAR; }
        bool part_ = false; if constexpr (Epi::HAS_MID) part_ = S.partial(cur);
        if constexpr (!Epi::AFTER_DRAIN) { if constexpr (Epi::HAS_MID) { if (part_) E.mid(acc, cur, wr, wc, fr, fq); else E(acc, cur, wr, wc, fr, fq); } else E(acc, cur, wr, wc, fr, fq); S.done(cur); }
        if (!has_next) break;
        if (!part_)
#pragma unroll
        for (int a = 0; a < 2; ++a)
#pragma unroll
            for (int b = 0; b < 2; ++b)
#pragma unroll
                for (int m = 0; m < 4; ++m)
#pragma unroll
                    for (int n = 0; n < 2; ++n) acc[a][b][m][n] = (f32x4){0.f, 0.f, 0.f, 0.f};
        cur = nxt; cA = nA; cB = nB; ++ui;
        if constexpr (ALIGN_EPI) { if (wr == 1) PG8_BAR; }
    }
    PG8_WAIT_V(0);
    if constexpr (!ALIGN_EPI) { if (wr == 0) PG8_BAR; }
    PG8_BAR;
    if constexpr (Epi::AFTER_DRAIN) { E.fused(acc, cur, wr, wc, fr, fq, lds, wid, lane); S.done(cur); }
#undef PG8_SA
#undef PG8_SB
#undef PG8_STAGE
#undef PG8_LDA
#undef PG8_LDB
#undef PG8_MMA
#undef PG8_WAIT_V
#undef PG8_WAIT_L
#undef PG8_BAR
#undef PG8_SCHED
}
}
namespace pg8 {
DI u32x4 pack8(f32x4 v0, f32x4 v1) { u32x4 w; w.x = pkbf(v0[0], v0[1]); w.y = pkbf(v0[2], v0[3]); w.z = pkbf(v1[0], v1[1]); w.w = pkbf(v1[2], v1[3]); return w; }
DI f32x4 sig4(f32x4 v) { f32x4 o; o[0] = sigmoid_f(v[0]); o[1] = sigmoid_f(v[1]); o[2] = sigmoid_f(v[2]); o[3] = sigmoid_f(v[3]); return o; }
DI float gelu_tanh(float x) { const float t = 1.5957691216f * (x + 0.044715f * x * x * x); return x * sigmoid_f(t); }
DI f32x4 gelu4(f32x4 v) { f32x4 o; o[0] = gelu_tanh(v[0]); o[1] = gelu_tanh(v[1]); o[2] = gelu_tanh(v[2]); o[3] = gelu_tanh(v[3]); return o; }
#define EPI_ROWS for (int ai = 0; ai < 2; ++ai) _Pragma("unroll") for (int m = 0; m < 4; ++m)

struct EpiIn {
    static constexpr bool PERM = true, AFTER_DRAIN = false, HAS_MID = false;
    bf16_t *Q, *Kb, *VT, *UC, *GATES; const float* b_gate;
    DI void operator()(const f32x4 (&acc)[2][2][4][2], const Unit& u, int wr, int wc, int fr, int fq) const {
        const int pn = u.pn, rbase = u.pm * BM + wr * 64 + fr, cb = wc * 32 + 8 * fq;
        if (pn < 4) {
            bf16_t* dst = pn < 2 ? Q : Kb; const float sc = pn < 2 ? 0.125f * 1.4426950408889634f : 1.0f;   const int c0 = (pn & 1) * 256 + cb;
#pragma unroll
            EPI_ROWS { const int row = rbase + ai * HALF + m * 16;
#pragma unroll
                for (int bj = 0; bj < 2; ++bj) *(u32x4*)(dst + (size_t)row * 512 + c0 + bj * HALF) = pack8(acc[ai][bj][m][0] * sc, acc[ai][bj][m][1] * sc); }
        } else if (pn < 6) {
#pragma unroll
            EPI_ROWS { const int row = rbase + ai * HALF + m * 16, b = row >> 12, s = row & 4095;
#pragma unroll
                for (int bj = 0; bj < 2; ++bj) { const int cv = (pn - 4) * 256 + bj * HALF + cb, h = cv >> 6, d = cv & 63;
                    bf16_t* p = VT + ((size_t)((b * 8 + h) * 64 + d)) * 4096 + s; const u32x4 w = pack8(acc[ai][bj][m][0] * 1.0f, acc[ai][bj][m][1] * 1.0f);
                    p[0] = (bf16_t)(w.x & 0xffffu); p[4096] = (bf16_t)(w.x >> 16); p[2 * 4096] = (bf16_t)(w.y & 0xffffu); p[3 * 4096] = (bf16_t)(w.y >> 16);
                    p[4 * 4096] = (bf16_t)(w.z & 0xffffu); p[5 * 4096] = (bf16_t)(w.z >> 16); p[6 * 4096] = (bf16_t)(w.w & 0xffffu); p[7 * 4096] = (bf16_t)(w.w >> 16); } }
        } else if (pn < 8) {
#pragma unroll
            EPI_ROWS { const int row = rbase + ai * HALF + m * 16, bc = row >> 6, j = row & 63;
#pragma unroll
                for (int bj = 0; bj < 2; ++bj) { const int cu = (pn - 6) * 256 + bj * HALF + cb, g = cu >> 4, hh = cu & 15;
                    *(u32x4*)(UC + ((size_t)(g * 1024 + bc)) * 1152 + 128 + j * 16 + hh) = pack8(acc[ai][bj][m][0] * 1.0f, acc[ai][bj][m][1] * 1.0f); } }
        } else {
#pragma unroll
            for (int bj = 0; bj < 2; ++bj) { const int cgt = (pn - 8) * 256 + bj * HALF + cb; const f32x4 b0 = *(const f32x4*)(b_gate + cgt), b1 = *(const f32x4*)(b_gate + cgt + 4);
#pragma unroll
                EPI_ROWS { const int row = rbase + ai * HALF + m * 16;
                    const f32x4 s0 = sig4(acc[ai][bj][m][0] + b0), s1 = sig4(acc[ai][bj][m][1] + b1);
                    *(u32x2*)((unsigned char*)GATES + (size_t)row * 2048 + cgt) = (u32x2){pk4u8(s0[0], s0[1], s0[2], s0[3]), pk4u8(s1[0], s1[1], s1[2], s1[3])}; } }
        }
    }
};
struct EpiSend {
    static constexpr bool PERM = true, AFTER_DRAIN = false, HAS_MID = false;
    float* SEND;
    DI void operator()(const f32x4 (&acc)[2][2][4][2], const Unit& u, int wr, int wc, int fr, int fq) const {
        const int g = u.pm >> 2, rbase = (u.pm & 3) * BM + wr * 64 + fr, c = wc * 32 + 8 * fq;
#pragma unroll
        EPI_ROWS { const int bc = rbase + ai * HALF + m * 16; float* p = SEND + ((size_t)bc * 32 + g) * 128 + c; *(f32x4*)p = acc[ai][0][m][0]; *(f32x4*)(p + 4) = acc[ai][0][m][1]; }
    }
};
struct EpiSsmOut {
    static constexpr bool PERM = true, AFTER_DRAIN = false, HAS_MID = false;
    bf16_t* YS;
    DI void operator()(const f32x4 (&acc)[2][2][4][2], const Unit& u, int wr, int wc, int fr, int fq) const {
        const int g = u.pm >> 2, rbase = (u.pm & 3) * BM + wr * 64 + fr, cb = (u.pn & 3) * BM + wc * 32 + 8 * fq;
#pragma unroll
        EPI_ROWS { const int bc = rbase + ai * HALF + m * 16;
#pragma unroll
            for (int bj = 0; bj < 2; ++bj) { const int n = cb + bj * HALF, i = n >> 4, h0 = n & 15;
                *(u32x4*)(YS + ((size_t)bc * 64 + i) * 512 + g * 16 + h0) = pack8(gelu4(acc[ai][bj][m][0]), gelu4(acc[ai][bj][m][1])); } }
    }
};
struct EpiGlu {
    static constexpr bool PERM = true, AFTER_DRAIN = false, HAS_MID = false;
    bf16_t* GLU;
    DI void operator()(const f32x4 (&acc)[2][2][4][2], const Unit& u, int wr, int wc, int fr, int fq) const {
        const int rbase = u.pm * BM + wr * 64 + fr, col = u.pn * HALF + wc * 32 + 8 * fq;
#pragma unroll
        EPI_ROWS { const int row = rbase + ai * HALF + m * 16;
            *(u32x4*)(GLU + (size_t)row * 1024 + 512 + col) = pack8(acc[ai][0][m][0] * sig4(acc[ai][1][m][0]), acc[ai][0][m][1] * sig4(acc[ai][1][m][1])); }
    }
};
struct EpiMix {
    static constexpr bool PERM = true, AFTER_DRAIN = false, HAS_MID = true;
    const bf16_t* GATES; bf16_t* MIXED;
    DI void mid(f32x4 (&acc)[2][2][4][2], const Unit& u, int wr, int wc, int fr, int fq) const {
        const unsigned char* gp = (const unsigned char*)GATES + (size_t)(u.pm * BM + wr * 64 + fr) * 2048 + u.pn * BM + wc * 32 + 8 * fq;
#pragma unroll
        EPI_ROWS {
#pragma unroll
            for (int bj = 0; bj < 2; ++bj) { const unsigned char* q = gp + (size_t)(ai * HALF + m * 16) * 2048 + bj * HALF; const u32x2 ga = *(const u32x2*)q, gb = *(const u32x2*)(q + 1024);
                f32x4 r0, r1;
#pragma unroll
                for (int e = 0; e < 4; ++e) { r0[e] = u8f(ga.x, e) * __builtin_amdgcn_rcpf(fmaxf(u8f(gb.x, e), 1e-18f)); r1[e] = u8f(ga.y, e) * __builtin_amdgcn_rcpf(fmaxf(u8f(gb.y, e), 1e-18f)); }
                acc[ai][bj][m][0] *= r0; acc[ai][bj][m][1] *= r1; }
            asm volatile("" ::: "memory"); }
    }
    DI void operator()(const f32x4 (&acc)[2][2][4][2], const Unit& u, int wr, int wc, int fr, int fq) const {
        const int rbase = u.pm * BM + wr * 64 + fr, cb = u.pn * BM + wc * 32 + 8 * fq;
#pragma unroll
        EPI_ROWS { const int row = rbase + ai * HALF + m * 16;
#pragma unroll
            for (int bj = 0; bj < 2; ++bj) { const int c = cb + bj * HALF; const u32x2 gb = *(const u32x2*)((const unsigned char*)GATES + (size_t)row * 2048 + 1024 + c);
                f32x4 b0, b1;
#pragma unroll
                for (int e = 0; e < 4; ++e) { b0[e] = fmaxf(u8f(gb.x, e), 1e-18f) * (1.0f / 255.0f); b1[e] = fmaxf(u8f(gb.y, e), 1e-18f) * (1.0f / 255.0f); }
                *(u32x4*)(MIXED + (size_t)row * 1024 + c) = pack8(acc[ai][bj][m][0] * b0, acc[ai][bj][m][1] * b1); } }
    }
};
template <bool BASE_BF16> struct EpiResid {
    static constexpr bool PERM = true, AFTER_DRAIN = false, HAS_MID = false;
    const float* basef; const bf16_t* baseb; bf16_t* HB; float* rowss;
    DI void operator()(const f32x4 (&acc)[2][2][4][2], const Unit& u, int wr, int wc, int fr, int fq) const {
        const int rbase = u.pm * BM + wr * 64 + fr, cb = u.pn * BM + wc * 32 + 8 * fq;
#pragma unroll
        EPI_ROWS { const int row = rbase + ai * HALF + m * 16; float ss = 0.f;
#pragma unroll
            for (int bj = 0; bj < 2; ++bj) { const size_t off = (size_t)row * 1024 + cb + bj * HALF; f32x4 b0, b1;
                if (BASE_BF16) { const u32x4 bw = *(const u32x4*)(baseb + off); b0 = (f32x4){bf_lo(bw.x), bf_hi(bw.x), bf_lo(bw.y), bf_hi(bw.y)}; b1 = (f32x4){bf_lo(bw.z), bf_hi(bw.z), bf_lo(bw.w), bf_hi(bw.w)}; }
                else { b0 = *(const f32x4*)(basef + off); b1 = *(const f32x4*)(basef + off + 4); }
                const f32x4 h0 = b0 + acc[ai][bj][m][0], h1 = b1 + acc[ai][bj][m][1];
                *(u32x4*)(HB + off) = pack8(h0, h1);
                ss += (h0[0] * h0[0] + h0[1] * h0[1]) + (h0[2] * h0[2] + h0[3] * h0[3]) + (h1[0] * h1[0] + h1[1] * h1[1]) + (h1[2] * h1[2] + h1[3] * h1[3]); }
            ss += __shfl_xor(ss, 16); ss += __shfl_xor(ss, 32);
            if (fq == 0) unsafeAtomicAdd(rowss + row, ss); }
    }
};
struct EpiFF1 {
    static constexpr bool PERM = true, AFTER_DRAIN = false, HAS_MID = false;
    const float* rowss; bf16_t* HID;
    DI void operator()(const f32x4 (&acc)[2][2][4][2], const Unit& u, int wr, int wc, int fr, int fq) const {
        const int rbase = u.pm * BM + wr * 64 + fr, cb = u.pn * BM + wc * 32 + 8 * fq;
#pragma unroll
        EPI_ROWS { const int row = rbase + ai * HALF + m * 16; const float rs = __builtin_amdgcn_rsqf(rowss[row] * (1.0f / 1024.0f) + 1e-6f);
#pragma unroll
            for (int bj = 0; bj < 2; ++bj) { f32x4 t0 = acc[ai][bj][m][0] * rs, t1 = acc[ai][bj][m][1] * rs;
                t0 = __builtin_elementwise_max(t0, (f32x4){0.f, 0.f, 0.f, 0.f}); t1 = __builtin_elementwise_max(t1, (f32x4){0.f, 0.f, 0.f, 0.f});
                *(u32x4*)(HID + (size_t)row * 4096 + cb + bj * HALF) = pack8(t0 * t0, t1 * t1); } }
    }
};
struct EndOrder {
    int G, c;
    DI bool next(int i, Unit& u) const { const int L = i * G + c; if (L >= 128) return false; u.pm = L; u.pn = L >> 2; return true; }
    DI int kt(const Unit&, int ntf) const { return ntf; }
    DI size_t koff(const Unit&) const { return 0; }
    DI void a_ready(const Unit&) const {}
    DI void done(const Unit&) const {}
};
struct OutOrder {
    int G, c;
    DI bool next(int i, Unit& u) const { const int P = (i >> 1) * G + c; if (P >= 256) return false; const int g = P >> 3, pmq = (P & 7) >> 1, a = P & 1, pnq = (i & 1) ? a : 3 - a; u.pm = g * 4 + pmq; u.pn = g * 4 + pnq; return true; }
    DI int kt(const Unit& u, int) const { return 2 + 4 * ((u.pn & 3) + 1); }
    DI size_t koff(const Unit&) const { return 0; }
    DI void a_ready(const Unit&) const {}
    DI void done(const Unit&) const {}
};
struct MixOrder {
    StaticOrder B;
    DI bool next(int i, Unit& u) const { if (!B.next(i >> 1, u)) return false; u.seg = i & 1; return true; }
    DI int kt(const Unit&, int) const { return 8; }
    DI size_t koff(const Unit& u) const { return (size_t)u.seg * 1024; }
    DI bool partial(const Unit& u) const { return u.seg == 0; }
    DI void a_ready(const Unit&) const {}
    DI void done(const Unit&) const {}
};
}
using pg8::bf16_t; using pg8::bf16x8; using pg8::f32x4; using pg8::u32x4;
#define LAS __attribute__((address_space(3)))
constexpr int TOK = 65536, DM = 1024, SEQ = 4096, NCH = 64, NBC = 1024;
constexpr size_t MiB = 1u << 20;
constexpr size_t WS_ROWSS1 = 0, WS_ROWSS2 = 256 * 1024;
constexpr size_t WS_BAR = 512 * 1024, BAR_BYTES = 16384 + 256, WS_QCTR = WS_BAR + 14336, WS_PCNT = WS_BAR + 16384;
constexpr size_t WS_WIN = 1 * MiB, WS_WGLU = 9 * MiB, WS_WAB = 10 * MiB, WS_WOUT = 12 * MiB, WS_WFF1 = 14 * MiB, WS_WFF2 = 22 * MiB;
constexpr size_t WS_MCAT = 30 * MiB;
constexpr size_t WS_WEND = 102 * MiB;
constexpr size_t WS_SEND = 111 * MiB;
constexpr size_t WS_UC = 128 * MiB;
constexpr size_t WS_XN = 200 * MiB;
constexpr size_t WS_MIXED = 328 * MiB;
constexpr size_t WS_Q = 328 * MiB;
constexpr size_t WS_K = 392 * MiB;
constexpr size_t WS_VT = 456 * MiB;
constexpr size_t WS_GATES = 520 * MiB;
constexpr size_t WS_HB = 776 * MiB;
constexpr size_t WS_HID = 264 * MiB;
constexpr size_t WS_ATT = 904 * MiB;
constexpr size_t WS_H2B = 128 * MiB;
constexpr size_t WS_END = 968 * MiB;
constexpr int LDS_BYTES = 147456;
constexpr float LOG2E = 1.4426950408889634f;

struct Args { const float* in[21]; float* out; unsigned char* ws; int ph_lo, ph_hi; };

DI float wave_sum(float v) {
#pragma unroll
    for (int o = 1; o < 64; o <<= 1) v += __shfl_xor(v, o);
    return v;
}
DI void transpose_item(const float* W, int K, int N, bf16_t* WT, const float* sc, LAS float* scr, int k0, int n0, int sn0, int lane) {
    float wv[32];
#pragma unroll
    for (int i = 0; i < 32; ++i) wv[i] = W[(size_t)(k0 + 2 * i + (lane >> 5)) * N + sn0 + (lane & 31)];
#pragma unroll
    for (int i = 0; i < 32; ++i) { const int kk = 2 * i + (lane >> 5); float v = wv[i]; if (sc) v *= sc[k0 + kk]; scr[kk * 33 + (lane & 31)] = v; }
    asm volatile("s_waitcnt lgkmcnt(0)" ::: "memory");
    const int c = lane & 7;
#pragma unroll
    for (int j = 0; j < 4; ++j) { const int n = (lane >> 3) + 8 * j; const LAS float* s = scr + (8 * c) * 33 + n;
        u32x4 o; o.x = pkbf(s[0 * 33], s[1 * 33]); o.y = pkbf(s[2 * 33], s[3 * 33]); o.z = pkbf(s[4 * 33], s[5 * 33]); o.w = pkbf(s[6 * 33], s[7 * 33]);
        *(u32x4*)(WT + (size_t)(n0 + n) * K + k0 + 8 * c) = o; }
    asm volatile("s_waitcnt lgkmcnt(0)" ::: "memory");
}
constexpr int SL = 130;
DI void ssm_precompute(LAS unsigned char* lds, const Args& a, unsigned char* ws, int blk, int tid) {
    const int g = blk >> 2, r = blk & 3;
    LAS float* L = (LAS float*)lds; LAS float* Cc = L + 65 * SL + 2;     LAS float* Bb = Cc + 16 * SL; LAS bf16_t* KtR = (LAS bf16_t*)(Bb + 2048);
    const float *a_re = a.in[5], *a_im = a.in[6], *log_dt = a.in[7], *b_re = a.in[8], *b_im = a.in[9], *c_re = a.in[10], *c_im = a.in[11], *dsk = a.in[12];
    const double dt = exp((double)log_dt[g]);
    if (tid < 64) { const int p = tid; const double zr = (double)a_re[g * 64 + p] * dt, zi = (double)a_im[g * 64 + p] * dt;
        double s, c; sincos(zi, &s, &c); const double e = exp(zr); const double lr = e * c, li = e * s; double pr = 1.0, pi_ = 0.0;
        for (int d = 0; d < 65; ++d) { L[d * SL + p * 2] = (float)pr; L[d * SL + p * 2 + 1] = (float)pi_; const double nr = pr * lr - pi_ * li; pi_ = pr * li + pi_ * lr; pr = nr; } }
    for (int idx = tid; idx < 1024; idx += 512) { const int p = idx >> 4; const double ar = a_re[g * 64 + p], ai = a_im[g * 64 + p]; const double zr = ar * dt, zi = ai * dt;
        double s, c; sincos(zi, &s, &c); const double e = exp(zr); const double nr = e * c - 1.0, ni = e * s, den = ar * ar + ai * ai;
        const double qr = (nr * ar + ni * ai) / den, qi = (ni * ar - nr * ai) / den;
        const double br = b_re[g * 1024 + idx], bi = b_im[g * 1024 + idx];
        Bb[idx * 2] = (float)(qr * br - qi * bi); Bb[idx * 2 + 1] = (float)(qr * bi + qi * br);
        const int ch = idx >> 6, cp = idx & 63;
        Cc[ch * SL + cp * 2] = c_re[g * 1024 + idx]; Cc[ch * SL + cp * 2 + 1] = c_im[g * 1024 + idx]; }
    __syncthreads();
    {
        const int h = tid & 15, d0 = tid >> 4, d1 = d0 + 32;
        float acc0[16], acc1[16];
#pragma unroll
        for (int e = 0; e < 16; ++e) { acc0[e] = 0.f; acc1[e] = 0.f; }
        for (int p = 0; p < 64; ++p) { const f32x2 cv = *(const LAS f32x2*)(Cc + h * SL + p * 2), l0 = *(const LAS f32x2*)(L + d0 * SL + p * 2), l1 = *(const LAS f32x2*)(L + d1 * SL + p * 2);
            const float w0r = cv[0] * l0[0] - cv[1] * l0[1], w0i = cv[0] * l0[1] + cv[1] * l0[0], w1r = cv[0] * l1[0] - cv[1] * l1[1], w1i = cv[0] * l1[1] + cv[1] * l1[0];
            const LAS f32x4* bp = (const LAS f32x4*)(Bb + p * 32);
#pragma unroll
            for (int e2 = 0; e2 < 8; ++e2) { const f32x4 bb = bp[e2];
                acc0[2 * e2] += w0r * bb[0] - w0i * bb[1]; acc0[2 * e2 + 1] += w0r * bb[2] - w0i * bb[3];
                acc1[2 * e2] += w1r * bb[0] - w1i * bb[1]; acc1[2 * e2 + 1] += w1r * bb[2] - w1i * bb[3]; } }
        if (d0 == 0) {
#pragma unroll
            for (int e = 0; e < 16; ++e) if (e == h) acc0[e] += dsk[g * 16 + h]; }
        u32x4 w0a, w0b, w1a, w1b;
        w0a.x = pkbf(acc0[0], acc0[1]); w0a.y = pkbf(acc0[2], acc0[3]); w0a.z = pkbf(acc0[4], acc0[5]); w0a.w = pkbf(acc0[6], acc0[7]);
        w0b.x = pkbf(acc0[8], acc0[9]); w0b.y = pkbf(acc0[10], acc0[11]); w0b.z = pkbf(acc0[12], acc0[13]); w0b.w = pkbf(acc0[14], acc0[15]);
        w1a.x = pkbf(acc1[0], acc1[1]); w1a.y = pkbf(acc1[2], acc1[3]); w1a.z = pkbf(acc1[4], acc1[5]); w1a.w = pkbf(acc1[6], acc1[7]);
        w1b.x = pkbf(acc1[8], acc1[9]); w1b.y = pkbf(acc1[10], acc1[11]); w1b.z = pkbf(acc1[12], acc1[13]); w1b.w = pkbf(acc1[14], acc1[15]);
        LAS u32x4* k0 = (LAS u32x4*)(KtR + (h * 64 + 63 - d0) * 16); LAS u32x4* k1 = (LAS u32x4*)(KtR + (h * 64 + 63 - d1) * 16);
        k0[0] = w0a; k0[1] = w0b; k1[0] = w1a; k1[1] = w1b;
    }
    __syncthreads();
    bf16_t* Mg = (bf16_t*)(ws + WS_MCAT) + (size_t)g * 1024 * 1152;
    for (int idx = tid; idx < 256 * 128; idx += 512) { const int rl = idx >> 7, qt = idx & 127, n = r * 256 + rl, i = n >> 4, h = n & 15;
        u32x4 w = {0u, 0u, 0u, 0u};
        if ((qt >> 1) <= i) w = *(const LAS u32x4*)(KtR + (h * 64 + 63 - i) * 16 + qt * 8);
        *(u32x4*)(Mg + (size_t)n * 1152 + 128 + qt * 8) = w; }
    for (int idx = tid; idx < 256 * 64; idx += 512) { const int rl = idx >> 6, pp = idx & 63, n = r * 256 + rl, i = n >> 4, h = n & 15, p = (2 * pp) & 63; const bool im = pp >= 32;
        const f32x2 c0 = *(const LAS f32x2*)(Cc + h * SL + p * 2), c1 = *(const LAS f32x2*)(Cc + h * SL + p * 2 + 2), l0 = *(const LAS f32x2*)(L + (i + 1) * SL + p * 2), l1 = *(const LAS f32x2*)(L + (i + 1) * SL + p * 2 + 2);
        const float v0 = im ? -(c0[0] * l0[1] + c0[1] * l0[0]) : (c0[0] * l0[0] - c0[1] * l0[1]), v1 = im ? -(c1[0] * l1[1] + c1[1] * l1[0]) : (c1[0] * l1[0] - c1[1] * l1[1]);
        *(unsigned*)(Mg + (size_t)n * 1152 + 2 * pp) = pkbf(v0, v1); }
    bf16_t* Wg = (bf16_t*)(ws + WS_WEND) + (size_t)g * 128 * 1024;
    for (int idx = tid; idx < 32 * 128; idx += 512) { const int rl = idx >> 7, q = idx & 127, n = r * 32 + rl, p = n & 63, j = q >> 1, h0 = (q & 1) * 8; const bool im = n >= 64;
        const float lr = L[(63 - j) * SL + p * 2], li = L[(63 - j) * SL + p * 2 + 1]; f32x4 v0, v1;
#pragma unroll
        for (int e = 0; e < 8; ++e) { const float br = Bb[(p * 16 + h0 + e) * 2], bi = Bb[(p * 16 + h0 + e) * 2 + 1]; const float val = im ? (lr * bi + li * br) : (lr * br - li * bi); if (e < 4) v0[e] = val; else v1[e - 4] = val; }
        *(u32x4*)(Wg + (size_t)n * 1024 + q * 8) = pg8::pack8(v0, v1); }
    __syncthreads();
}
DI void prologue(LAS unsigned char* lds, const Args& a, unsigned char* ws, int blk, int G, int tid) {
    const int lane = tid & 63, wave = tid >> 6;
    float* rss = (float*)(ws + WS_ROWSS1);
    for (int i = blk * 512 + tid; i < 2 * TOK; i += G * 512) rss[i] = 0.f;
    for (int sb = blk; sb < 128; sb += G) ssm_precompute(lds, a, ws, sb, tid);
    LAS float* scr = (LAS float*)(lds + wave * 16384);
    constexpr int I_IN = 16 * 128, I_GLU = 8 * 32, I_A = 8 * 32, I_B = 8 * 32, I_OUT = 16 * 32, I_F1 = 16 * 128, I_F2 = 64 * 32;
    constexpr int NITEMS = I_IN + I_GLU + I_A + I_B + I_OUT + I_F1 + I_F2, NXN = TOK / 16;
    unsigned* qctr = (unsigned*)(ws + WS_QCTR);
    const float* x = a.in[0]; const f32x4* gm = (const f32x4*)a.in[1] + lane; bf16_t* XN = (bf16_t*)(ws + WS_XN);
    int shard_i = 0;
    for (;;) {
        const int shard = (blk + shard_i) & 7;
        int it = 0; if (lane == 0) it = (int)__hip_atomic_fetch_add(qctr + shard * 64, 1u, __ATOMIC_RELAXED, __HIP_MEMORY_SCOPE_AGENT);
        it = __builtin_amdgcn_readfirstlane(it) * 8 + shard;
        if (it >= NITEMS + NXN) { if (++shard_i == 8) break; continue; }
        if (it >= NITEMS) {
            const int m0 = (it - NITEMS) * 16;
            f32x4 gv[4];
#pragma unroll
            for (int j = 0; j < 4; ++j) gv[j] = gm[64 * j];
            for (int mb = m0; mb < m0 + 16; mb += 4) {
                f32x4 v[4][4];
#pragma unroll
                for (int r = 0; r < 4; ++r) { const f32x4* xr = (const f32x4*)(x + (size_t)(mb + r) * DM) + lane;
#pragma unroll
                    for (int j = 0; j < 4; ++j) v[r][j] = xr[64 * j]; }
#pragma unroll
                for (int r = 0; r < 4; ++r) { float s = 0.f;
#pragma unroll
                    for (int j = 0; j < 4; ++j) s += (v[r][j][0] * v[r][j][0] + v[r][j][1] * v[r][j][1]) + (v[r][j][2] * v[r][j][2] + v[r][j][3] * v[r][j][3]);
                    const float rs = 1.0f / sqrtf(wave_sum(s) * (1.0f / DM) + 1e-6f);
                    u32x2* o8 = (u32x2*)(XN + (size_t)(mb + r) * DM) + lane;
#pragma unroll
                    for (int j = 0; j < 4; ++j) { const f32x4 t = v[r][j] * rs * gv[j]; u32x2 w; w.x = pkbf(t[0], t[1]); w.y = pkbf(t[2], t[3]); o8[64 * j] = w; } } }
            continue;
        }
        int rr = it;
        if (rr < I_IN) { transpose_item(a.in[2], 1024, 4096, (bf16_t*)(ws + WS_WIN), nullptr, scr, 64 * (rr / 128), 32 * (rr % 128), 32 * (rr % 128), lane); continue; } rr -= I_IN;
        if (rr < I_GLU) { const int n0 = 32 * (rr % 32), sn0 = ((n0 & 255) >> 7) * 512 + 128 * (n0 >> 8) + (n0 & 127);
            transpose_item(a.in[13], 512, 1024, (bf16_t*)(ws + WS_WGLU), nullptr, scr, 64 * (rr / 32), n0, sn0, lane); continue; } rr -= I_GLU;
        if (rr < I_A) { transpose_item(a.in[14], 1024, 1024, (bf16_t*)(ws + WS_WAB), nullptr, scr, 64 * (rr / 32), 32 * (rr % 32), 32 * (rr % 32), lane); continue; } rr -= I_A;
        if (rr < I_B) { transpose_item(a.in[15], 1024, 1024, (bf16_t*)(ws + WS_WAB) + 512, nullptr, scr, 64 * (rr / 32), 32 * (rr % 32), 32 * (rr % 32), lane); continue; } rr -= I_B;
        if (rr < I_OUT) { transpose_item(a.in[16], 1024, 1024, (bf16_t*)(ws + WS_WOUT), nullptr, scr, 64 * (rr / 32), 32 * (rr % 32), 32 * (rr % 32), lane); continue; } rr -= I_OUT;
        if (rr < I_F1) { transpose_item(a.in[18], 1024, 4096, (bf16_t*)(ws + WS_WFF1), a.in[17], scr, 64 * (rr / 128), 32 * (rr % 128), 32 * (rr % 128), lane); continue; } rr -= I_F1;
        transpose_item(a.in[19], 4096, 1024, (bf16_t*)(ws + WS_WFF2), nullptr, scr, 64 * (rr / 32), 32 * (rr % 32), 32 * (rr % 32), lane);
    }
    __syncthreads();
}
#define MFMA32(a, b, c) __builtin_amdgcn_mfma_f32_32x32x16_bf16((a), (b), (c), 0, 0, 0)
DI int crow(int reg, int hh) { return (reg & 3) + 8 * (reg >> 2) + 4 * hh; }
constexpr int AT_KROW = 144, AT_VROW = 136, AT_KBUF = 64 * AT_KROW, AT_VBUF = 64 * AT_VROW, AT_BUF = AT_KBUF + AT_VBUF, AT_BIAS = 2 * AT_BUF, AT_TILES = 40960;
DI void attn_phase(LAS unsigned char* lds, const bf16_t* Q, bf16_t* ATT, const bf16_t* Kb, const bf16_t* VT, const float* rel_bias, unsigned* actr, int tid) {
    const int wave = tid >> 6, lane = tid & 63, c32 = lane & 31, hh = lane >> 5;
    LAS float* bt = (LAS float*)(lds + AT_BIAS); volatile LAS int* uq = (volatile LAS int*)(lds + AT_BIAS + 2048);
    const int srow = tid >> 3, spc = tid & 7;
    __syncthreads();
    if (tid == 0) uq[0] = (int)__hip_atomic_fetch_add(actr, 1u, __ATOMIC_RELAXED, __HIP_MEMORY_SCOPE_AGENT);
    __syncthreads();
    int cur = uq[0];
    {
        while (cur < 2048) {
            int nxt_ticket = 0;
            if (tid == 0) nxt_ticket = (int)__hip_atomic_fetch_add(actr, 1u, __ATOMIC_RELAXED, __HIP_MEMORY_SCOPE_AGENT);
            const int rank = cur >> 7, bh = cur & 127, b = bh >> 3, h = bh & 7, gidx = rank < 14 ? rank + 2 : 15 - rank;
            if (tid < 257) bt[tid] = rel_bias[h * 257 + tid] * LOG2E;
            __syncthreads();
            {
                LAS float* BT = (LAS float*)(lds + AT_TILES);
                for (int idx = tid; idx < 7 * 1024; idx += 512) { const int t = idx >> 10, q = (idx >> 8) & 3, ln = (idx >> 2) & 63, r = idx & 3;
                    int id = 32 * t - 32 + (ln & 31) - crow(4 * q + r, ln >> 5) + 128; id = id < 0 ? 0 : (id > 256 ? 256 : id); BT[idx] = bt[id]; }
            }
            const bf16_t* kg = Kb + ((size_t)b * SEQ + srow) * 512 + h * 64 + spc * 8;
            const bf16_t* vg = VT + ((size_t)(bh * 64 + srow)) * 4096 + spc * 8;
            const int n0 = gidx * 4, n = n0 + (wave >> 1), qi = (wave & 1) * 32 + c32;
            const int kc_lo = n0 >= 8 ? n0 - 8 : 0, kc_hi = n0 + 3;
            const size_t tok = (size_t)b * SEQ + n * 64 + qi;
            const bf16_t* qp = Q + tok * 512 + h * 64 + 32 * hh;
            bf16x8 qf[4];
#pragma unroll
            for (int s = 0; s < 4; ++s) qf[s] = *(const bf16x8*)(qp + 8 * s);
            f32x16 O0, O1;
#pragma unroll
            for (int e = 0; e < 16; ++e) { O0[e] = 0.f; O1[e] = 0.f; }
            float mref = 0.f, lsum = 0.f; bool fresh = true;
            u32x4 kreg = *(const u32x4*)(kg + (size_t)kc_lo * 64 * 512), vreg = *(const u32x4*)(vg + kc_lo * 64);
            for (int kc = kc_lo; kc <= kc_hi; ++kc) {
                LAS unsigned char* kb_ = lds + ((kc - kc_lo) & 1) * AT_BUF; LAS unsigned char* vb_ = kb_ + AT_KBUF;
                *(LAS u32x4*)(kb_ + srow * AT_KROW + spc * 16) = kreg;
                *(LAS u32x2*)(vb_ + srow * AT_VROW + spc * 16) = (u32x2){vreg.x, vreg.y}; *(LAS u32x2*)(vb_ + srow * AT_VROW + spc * 16 + 8) = (u32x2){vreg.z, vreg.w};
                __syncthreads();
                if (kc < kc_hi) { kreg = *(const u32x4*)(kg + (size_t)(kc + 1) * 64 * 512); vreg = *(const u32x4*)(vg + (kc + 1) * 64); }
                const int delta = n - kc;
                if (delta >= 0 && delta <= 8) {
                    f32x16 S0, S1;
                    if (delta >= 3) { const float ci = bt[256] - mref;
#pragma unroll
                        for (int e = 0; e < 16; ++e) { S0[e] = ci; S1[e] = ci; }
                    } else { const int qh = wave & 1; const LAS f32x4* t0p = (const LAS f32x4*)(lds + AT_TILES) + (2 * delta + qh + 1) * 256 + lane; const LAS f32x4* t1p = t0p - 256;
#pragma unroll
                        for (int q = 0; q < 4; ++q) { const f32x4 ta = t0p[q * 64], tb = t1p[q * 64];
#pragma unroll
                            for (int r = 0; r < 4; ++r) { S0[4 * q + r] = ta[r] - mref; S1[4 * q + r] = tb[r] - mref; } }
                    }
                    const LAS unsigned char* kp = kb_ + c32 * AT_KROW + 64 * hh;
#pragma unroll
                    for (int s = 0; s < 4; ++s) { const bf16x8 k0 = *(const LAS bf16x8*)(kp + 16 * s), k1 = *(const LAS bf16x8*)(kp + 32 * AT_KROW + 16 * s);
                        S0 = MFMA32(k0, qf[s], S0); S1 = MFMA32(k1, qf[s], S1); }
                    float cm = fmaxf(S0[0], S1[0]);
#pragma unroll
                    for (int e = 1; e < 16; ++e) cm = fmaxf(fmaxf(cm, S0[e]), S1[e]);
                    cm = fmaxf(cm, __shfl_xor(cm, 32));
                    if (fresh || __any(cm > 20.0f)) {
                        const float dm = (fresh || cm > 20.0f) ? cm : 0.f, sc = fresh ? 1.0f : __builtin_amdgcn_exp2f(-dm);
                        mref += dm; lsum *= sc;
#pragma unroll
                        for (int e = 0; e < 16; ++e) { S0[e] -= dm; S1[e] -= dm; O0[e] *= sc; O1[e] *= sc; }
                        fresh = false;
                    }
                    f32x2 ps2 = {0.f, 0.f};
#pragma unroll
                    for (int e = 0; e < 16; e += 2) { S0[e] = __builtin_amdgcn_exp2f(S0[e]); S0[e + 1] = __builtin_amdgcn_exp2f(S0[e + 1]); S1[e] = __builtin_amdgcn_exp2f(S1[e]); S1[e + 1] = __builtin_amdgcn_exp2f(S1[e + 1]);
                        ps2 += (f32x2){S0[e], S0[e + 1]}; ps2 += (f32x2){S1[e], S1[e + 1]}; }
                    lsum += ps2[0] + ps2[1];
                    const LAS unsigned char* vp = vb_ + c32 * AT_VROW + 8 * hh;
#pragma unroll
                    for (int kt = 0; kt < 2; ++kt)
#pragma unroll
                        for (int s2 = 0; s2 < 2; ++s2) {
                            const f32x16& S = kt ? S1 : S0;
                            u32x4 pw; pw.x = pkbf(S[8 * s2], S[8 * s2 + 1]); pw.y = pkbf(S[8 * s2 + 2], S[8 * s2 + 3]); pw.z = pkbf(S[8 * s2 + 4], S[8 * s2 + 5]); pw.w = pkbf(S[8 * s2 + 6], S[8 * s2 + 7]);
                            const bf16x8 pf = __builtin_bit_cast(bf16x8, pw);
                            const LAS unsigned char* v0p = vp + (32 * kt + 16 * s2) * 2;
                            const s16x4 a0 = *(const LAS s16x4*)v0p, a1 = *(const LAS s16x4*)(v0p + 16), c0 = *(const LAS s16x4*)(v0p + 32 * AT_VROW), c1 = *(const LAS s16x4*)(v0p + 32 * AT_VROW + 16);
                            const bf16x8 vf0 = {a0[0], a0[1], a0[2], a0[3], a1[0], a1[1], a1[2], a1[3]}, vf1 = {c0[0], c0[1], c0[2], c0[3], c1[0], c1[1], c1[2], c1[3]};
                            O0 = MFMA32(vf0, pf, O0); O1 = MFMA32(vf1, pf, O1);
                        }
                }
            }
            lsum += __shfl_xor(lsum, 32);
            const float inv = 1.0f / lsum;
            bf16_t* op = ATT + tok * 1024 + h * 64 + 4 * hh;
#pragma unroll
            for (int gq = 0; gq < 4; ++gq) { u32x2 w0, w1; w0.x = pkbf(O0[4 * gq] * inv, O0[4 * gq + 1] * inv); w0.y = pkbf(O0[4 * gq + 2] * inv, O0[4 * gq + 3] * inv);
                w1.x = pkbf(O1[4 * gq] * inv, O1[4 * gq + 1] * inv); w1.y = pkbf(O1[4 * gq + 2] * inv, O1[4 * gq + 3] * inv);
                *(u32x2*)(op + 8 * gq) = w0; *(u32x2*)(op + 32 + 8 * gq) = w1; }
            if (tid == 0) uq[0] = nxt_ticket;
            __syncthreads();
            cur = uq[0];
        }
    }
    __syncthreads();
}
DI void carry_scan(const Args& a, unsigned char* ws, int blk, int G, int tid) {
    const float* SEND = (const float*)(ws + WS_SEND); bf16_t* UC = (bf16_t*)(ws + WS_UC);
    if (tid < 128)
    for (int idx = blk * 128 + tid; idx < 32768; idx += G * 128) {
        const int p = idx & 63, g = (idx >> 6) & 31, b = idx >> 11;
        const float* sp = SEND + ((size_t)(b * 64) * 32 + g) * 128 + p;
        float sr[64], si[64];
#pragma unroll
        for (int ch = 0; ch < 64; ++ch) { sr[ch] = sp[(size_t)ch * 4096]; si[ch] = sp[(size_t)ch * 4096 + 64]; }
        const double dt = exp((double)a.in[7][g]); const double zr = (double)a.in[5][g * 64 + p] * dt * 64.0, zi = (double)a.in[6][g * 64 + p] * dt * 64.0;
        double s, c; sincos(zi, &s, &c); const double e = exp(zr); const float lr = (float)(e * c), li = (float)(e * s);
        float cr = 0.f, ci = 0.f;
        bf16_t* up = UC + ((size_t)(g * 1024 + b * 64)) * 1152 + p;
#pragma unroll
        for (int ch = 0; ch < 64; ++ch) { const unsigned w = pkbf(cr, ci); up[(size_t)ch * 1152] = (bf16_t)(w & 0xffffu); up[(size_t)ch * 1152 + 64] = (bf16_t)(w >> 16);
            const float nr = lr * cr - li * ci + sr[ch], ni = lr * ci + li * cr + si[ch]; cr = nr; ci = ni; }
    }
}
DI void final_norm(const Args& a, unsigned char* ws, int blk, int G, int tid) {
    const int lane = tid & 63, wave = tid >> 6, gw = blk * 8 + wave, NGW = G * 8;
    const float* rss = (const float*)(ws + WS_ROWSS2); const bf16_t* H2B = (const bf16_t*)(ws + WS_H2B);
    const f32x4* gm = (const f32x4*)a.in[20] + 2 * lane;
    f32x4 gv[2][2];
#pragma unroll
    for (int j = 0; j < 2; ++j) { gv[j][0] = gm[128 * j]; gv[j][1] = gm[128 * j + 1]; }
    for (int m = gw; m < TOK; m += 4 * NGW) {
        u32x4 w[4][2]; float rs[4];
#pragma unroll
        for (int r = 0; r < 4; ++r) { const int mm = m + r * NGW; if (mm < TOK) { const u32x4* hp = (const u32x4*)(H2B + (size_t)mm * DM) + lane; w[r][0] = hp[0]; w[r][1] = hp[64]; rs[r] = rss[mm]; } }
#pragma unroll
        for (int r = 0; r < 4; ++r) { const int mm = m + r * NGW; if (mm < TOK) { const float sc = 1.0f / sqrtf(rs[r] * (1.0f / DM) + 1e-6f); f32x4* o = (f32x4*)(a.out + (size_t)mm * DM) + 2 * lane;
#pragma unroll
            for (int j = 0; j < 2; ++j) { const u32x4 ww = w[r][j];
                o[128 * j] = (f32x4){bf_lo(ww.x), bf_hi(ww.x), bf_lo(ww.y), bf_hi(ww.y)} * sc * gv[j][0]; o[128 * j + 1] = (f32x4){bf_lo(ww.z), bf_hi(ww.z), bf_lo(ww.w), bf_hi(ww.w)} * sc * gv[j][1]; } } } }
}
#define XB_TMO      128
#define XB_XCNT(j)  (256  + 64 * (j))
#define XB_XSUB(j)  (1280 + 64 * (j))
#define XB_XGEN(j)  (2304 + 64 * (j))
#define XB_TOP      3328
#define XB_TOPGEN   3392
#define XCD_BAR_WORDS 3456
#define XB_SPIN_CAP (1u << 18)

__device__ __forceinline__ unsigned xb_ld(unsigned* p)              { return __hip_atomic_load(p, __ATOMIC_RELAXED, __HIP_MEMORY_SCOPE_AGENT); }
__device__ __forceinline__ unsigned xb_add(unsigned* p, unsigned v) { return __hip_atomic_fetch_add(p, v, __ATOMIC_RELAXED, __HIP_MEMORY_SCOPE_AGENT); }
__device__ __forceinline__ unsigned xb_xcc_id() { return (unsigned)__builtin_amdgcn_s_getreg((3 << 11) | 20) & 0xFu; }
#define XB_SPIN(cond, bar) do { unsigned _sp = 0; while (cond) { __builtin_amdgcn_s_sleep(1); \
    if ((++_sp & 255u) == 0u) { if (xb_ld(&(bar)[XB_TMO])) break; if (_sp > XB_SPIN_CAP) { atomicAdd(&(bar)[XB_TMO], 1u); break; } } } } while (0)

struct XcdBarrier {
    unsigned* bar; unsigned x;
    volatile LAS unsigned* st;
};

__device__ __forceinline__ XcdBarrier xcd_barrier_post(unsigned* bar, volatile LAS unsigned* st) {
    XcdBarrier b; b.bar = bar; b.x = xb_xcc_id(); b.st = st;
    if (threadIdx.x == 0) (void)xb_add(&bar[XB_XCNT(b.x)], 1u);
    return b;
}
__device__ __forceinline__ void xcd_barrier_complete(unsigned* bar, unsigned x, unsigned& nloc, unsigned& nx) {
    const unsigned G = gridDim.x * gridDim.y * gridDim.z;
    unsigned sum, cnt, mine, sp = 0u;
    for (;;) {
        sum = 0u; cnt = 0u; mine = 0u;
#pragma unroll
        for (unsigned j = 0; j < 16; ++j) { const unsigned c = xb_ld(&bar[XB_XCNT(j)]); sum += c; cnt += (c > 0u) ? 1u : 0u; mine = (j == x) ? c : mine; }
        if (sum == G) break;
        __builtin_amdgcn_s_sleep(1);
        if ((++sp & 255u) == 0u) { if (xb_ld(&bar[XB_TMO])) break; if (sp > XB_SPIN_CAP) { atomicAdd(&bar[XB_TMO], 1u); break; } }
    }
    nloc = mine > 0u ? mine : 1u; nx = cnt > 0u ? cnt : 1u;
}

__device__ __forceinline__ void xcd_barrier(const XcdBarrier& b) {
    asm volatile("s_waitcnt vmcnt(0)" ::: "memory");
    __syncthreads();
    if (threadIdx.x == 0) {
        unsigned* bar = b.bar;
        __builtin_amdgcn_s_waitcnt(0);
        unsigned nloc = b.st[0], nx = b.st[1];
        if (nloc == 0u) { xcd_barrier_complete(bar, b.x, nloc, nx); b.st[0] = nloc; b.st[1] = nx; }
        const unsigned old = xb_add(&bar[XB_XSUB(b.x)], 1u);
        const unsigned gen = old / nloc;
        if (old + 1u == (gen + 1u) * nloc) {
            __builtin_amdgcn_fence(__ATOMIC_RELEASE, "agent");
            asm volatile("s_waitcnt vmcnt(0)" ::: "memory");
            const unsigned og = xb_add(&bar[XB_TOP], 1u);
            const unsigned tg = og / nx;
            if (og + 1u == (tg + 1u) * nx) xb_add(&bar[XB_TOPGEN], 1u);
            else XB_SPIN(xb_ld(&bar[XB_TOPGEN]) == tg, bar);
            __builtin_amdgcn_fence(__ATOMIC_ACQUIRE, "agent");
            xb_add(&bar[XB_XGEN(b.x)], 1u);
            asm volatile("s_waitcnt vmcnt(0)" ::: "memory");
        } else {
            XB_SPIN(xb_ld(&bar[XB_XGEN(b.x)]) == gen, bar);
            __builtin_amdgcn_fence(__ATOMIC_ACQUIRE, "agent");
            asm volatile("s_waitcnt vmcnt(0)" ::: "memory");
        }
    }
    __syncthreads();
}

constexpr int N_PHASES = 11;
constexpr int LDS_BARST = 131072 + 64;
template <bool COOP> __global__ void __launch_bounds__(512, 2) fwd(Args a) {
    extern __shared__ __attribute__((aligned(16))) unsigned char lds_raw[];
    LAS unsigned char* lds = (LAS unsigned char*)lds_raw;
    const int tid = threadIdx.x, blk = blockIdx.x, G = gridDim.x; unsigned char* ws = a.ws;
    const int lo = a.ph_lo, hi = a.ph_hi;
#ifndef PROBE_PHASE
#define PROBE_PHASE -1
#endif
#define IN(k) (lo <= (k) && (k) < hi)
#define REP(k) for (int rep_ = 0; rep_ < ((k) == PROBE_PHASE ? 2 : 1); ++rep_)
#define SEAM(k) do { if constexpr (COOP) { if (IN(k) && IN((k) + 1)) xcd_barrier(bar); } } while (0)
    bf16_t *WIN = (bf16_t*)(ws + WS_WIN), *WGLU = (bf16_t*)(ws + WS_WGLU), *WAB = (bf16_t*)(ws + WS_WAB), *WOUT = (bf16_t*)(ws + WS_WOUT), *WFF1 = (bf16_t*)(ws + WS_WFF1), *WFF2 = (bf16_t*)(ws + WS_WFF2);
    bf16_t *MCAT = (bf16_t*)(ws + WS_MCAT), *WEND = (bf16_t*)(ws + WS_WEND), *UC = (bf16_t*)(ws + WS_UC), *XN = (bf16_t*)(ws + WS_XN), *AG = XN, *MIXED = (bf16_t*)(ws + WS_MIXED), *Qb = (bf16_t*)(ws + WS_Q), *Kb = (bf16_t*)(ws + WS_K), *YS = Kb;
    bf16_t *VT = (bf16_t*)(ws + WS_VT), *GATES = (bf16_t*)(ws + WS_GATES), *HB = (bf16_t*)(ws + WS_HB), *HID = (bf16_t*)(ws + WS_HID);
    float *SEND = (float*)(ws + WS_SEND), *RSS1 = (float*)(ws + WS_ROWSS1), *RSS2 = (float*)(ws + WS_ROWSS2);
    using namespace pg8;
    XcdBarrier bar; bar.bar = (unsigned*)(ws + WS_BAR); bar.x = 0; bar.st = (volatile LAS unsigned*)(lds + LDS_BARST);
    if constexpr (COOP) {
        if (tid == 0) { bar.st[0] = 0u; bar.st[1] = 0u; }
        __syncthreads();
        bar = xcd_barrier_post((unsigned*)(ws + WS_BAR), (volatile LAS unsigned*)(lds + LDS_BARST));
        if (hi > N_PHASES) cg::this_grid().sync();
    }
    if (IN(0)) REP(0) { prologue(lds, a, ws, blk, G, tid); }
    SEAM(0);
    if (IN(1)) REP(1) { Gemm g{XN, WIN, 1024, 1024, 1024, 256}; StaticOrder S; S.init(TOK, 4096, G, blk); EpiIn E{Qb, Kb, VT, UC, GATES, a.in[3]};
        gemm_phase<EpiIn, StaticOrder, true, true>(lds, g, S, E); }
    SEAM(1);
    if (IN(2)) REP(2) { { Gemm g{UC + 128, WEND, 1024, 1152, 1024, 128}; EndOrder S{G, blk}; EpiSend E{SEND}; gemm_phase<EpiSend, EndOrder, true, true>(lds, g, S, E); }
        attn_phase(lds, Qb, AG, Kb, VT, a.in[4], (unsigned*)(ws + WS_PCNT), tid); }
    SEAM(2);
    if (IN(3)) REP(3) { carry_scan(a, ws, blk, G, tid); }
    SEAM(3);
    if (IN(4)) REP(4) { Gemm g{UC, MCAT, 1152, 1152, 1152, 256}; OutOrder S{G, blk}; EpiSsmOut E{YS}; gemm_phase<EpiSsmOut, OutOrder, true, true>(lds, g, S, E); }
    SEAM(4);
    if (IN(5)) REP(5) { Gemm g{YS, WGLU, 512, 512, 512, 256}; StaticOrder S; S.init(TOK, 1024, G, blk); EpiGlu E{AG}; gemm_phase<EpiGlu, StaticOrder, true, true>(lds, g, S, E); }
    SEAM(5);
    if (IN(6)) REP(6) { Gemm g{AG, WAB, 1024, 1024, 1024, 256}; MixOrder S; S.B.init(TOK, 1024, G, blk); EpiMix E{GATES, MIXED}; gemm_phase<EpiMix, MixOrder, true, true>(lds, g, S, E); }
    SEAM(6);
    if (IN(7)) REP(7) { Gemm g{MIXED, WOUT, 1024, 1024, 1024, 256}; StaticOrder S; S.init(TOK, 1024, G, blk); EpiResid<false> E{a.in[0], nullptr, HB, RSS1};
        gemm_phase<EpiResid<false>, StaticOrder, true, true>(lds, g, S, E); }
    SEAM(7);
    if (IN(8)) REP(8) { Gemm g{HB, WFF1, 1024, 1024, 1024, 256}; StaticOrder S; S.init(TOK, 4096, G, blk); EpiFF1 E{RSS1, HID}; gemm_phase<EpiFF1, StaticOrder, true, true>(lds, g, S, E); }
    SEAM(8);
    if (IN(9)) REP(9) { Gemm g{HID, WFF2, 4096, 4096, 4096, 256}; StaticOrder S; S.init(TOK, 1024, G, blk); EpiResid<true> E{nullptr, HB, (bf16_t*)(ws + WS_H2B), RSS2};
        gemm_phase<EpiResid<true>, StaticOrder, true, true>(lds, g, S, E); }
    SEAM(9);
    if (IN(10)) REP(10) { final_norm(a, ws, blk, G, tid); }
#undef IN
#undef SEAM
}
extern "C" void kernel_launch(void* const* d_in, const int* in_sizes, int n_in, void* d_out, int out_size, void* d_ws, size_t ws_size, hipStream_t stream) {
    static int grid = 0;
    if (grid == 0) {
        if (n_in != 21 || in_sizes[0] != TOK * DM || out_size != TOK * DM || ws_size < WS_END) { fprintf(stderr, "kernel_launch: unexpected shapes (n_in %d, in0 %d, out %d, ws %zu)\n", n_in, n_in > 0 ? in_sizes[0] : -1, out_size, ws_size); grid = -1; return; }
        int dev = 0, cus = 0, per_cu = 0;
        hipGetDevice(&dev); hipDeviceGetAttribute(&cus, hipDeviceAttributeMultiprocessorCount, dev);
        hipFuncSetAttribute((const void*)fwd<true>, hipFuncAttributeMaxDynamicSharedMemorySize, LDS_BYTES);
        hipFuncSetAttribute((const void*)fwd<false>, hipFuncAttributeMaxDynamicSharedMemorySize, LDS_BYTES);
        hipOccupancyMaxActiveBlocksPerMultiprocessor(&per_cu, (const void*)fwd<true>, 512, LDS_BYTES);
        (void)hipGetLastError();
        if (per_cu < 1) { fprintf(stderr, "kernel_launch: occupancy query says %d workgroups per CU\n", per_cu); per_cu = 1; }
        grid = cus;
        if (grid > 256) grid = 256;
    }
    if (grid < 0) return;
    Args a{};
    for (int i = 0; i < 21; ++i) a.in[i] = (const float*)d_in[i];
    a.out = (float*)d_out; a.ws = (unsigned char*)d_ws;
    if (hipMemsetAsync((char*)d_ws + WS_BAR, 0, BAR_BYTES, stream) != hipSuccess) { fprintf(stderr, "kernel_launch: memset of the barrier words failed\n"); return; }
#if ONE_LAUNCH
    a.ph_lo = 0; a.ph_hi = N_PHASES;
    void* args[] = {&a};
    hipError_t e = hipLaunchCooperativeKernel((const void*)fwd<true>, dim3(grid), dim3(512), args, LDS_BYTES, stream);
    if (e != hipSuccess) fprintf(stderr, "cooperative launch failed: %s (grid %d)\n", hipGetErrorString(e), grid);
#else
    for (int li = 0; li < N_PHASES; ++li) { a.ph_lo = li; a.ph_hi = li + 1; hipLaunchKernelGGL(fwd<false>, dim3(grid), dim3(512), LDS_BYTES, stream, a); }
#endif
}
```

```cpp
#include <hip/hip_runtime.h>
#include <hip/hip_cooperative_groups.h>
#include <cstdio>
#include <cstdint>
namespace cg = cooperative_groups;
#ifndef ONE_LAUNCH
#define ONE_LAUNCH 1
#endif
#define DI __device__ __forceinline__
typedef float f32x2 __attribute__((ext_vector_type(2)));
typedef float f32x16 __attribute__((ext_vector_type(16)));
typedef unsigned u32x2 __attribute__((ext_vector_type(2)));
typedef short s16x4 __attribute__((ext_vector_type(4)));
typedef __bf16 bf2_t __attribute__((ext_vector_type(2)));
DI unsigned pkbf(float lo, float hi) { f32x2 v = {lo, hi}; return __builtin_bit_cast(unsigned, __builtin_convertvector(v, bf2_t)); }
DI float bf_lo(unsigned w) { return __uint_as_float(w << 16); }
DI float bf_hi(unsigned w) { return __uint_as_float(w & 0xffff0000u); }
DI float sigmoid_f(float x) { return __builtin_amdgcn_rcpf(1.0f + __expf(-x)); }
DI unsigned pk4u8(float a, float b, float c, float d) { return (unsigned)(a * 255.0f + 0.5f) | ((unsigned)(b * 255.0f + 0.5f) << 8) | ((unsigned)(c * 255.0f + 0.5f) << 16) | ((unsigned)(d * 255.0f + 0.5f) << 24); }
DI float u8f(unsigned w, int e) { return (float)((w >> (8 * e)) & 0xffu); }
namespace pg8 {
#define PG8_LAS __attribute__((address_space(3)))
typedef unsigned short bf16_t;
typedef short bf16x8 __attribute__((ext_vector_type(8)));
typedef float f32x4 __attribute__((ext_vector_type(4)));
typedef unsigned u32x4 __attribute__((ext_vector_type(4)));
constexpr int BM = 256, BK = 64, HALF = 128, HTB = HALF * BK * 2  , STAGE_BYTES = 8 * HTB, NXCD = 8, WGM = 8;

__host__ __device__ __forceinline__ int lds_byte(int r, int c) { const int st = (r >> 4) * 2 + (c >> 5), rr = r & 15, cc = c & 31, ob = rr * 64 + cc * 2; return st * 1024 + (ob ^ (((ob >> 9) & 1) << 5)); }
__host__ __device__ __forceinline__ void stage_rc(int b, int& R, int& C) { const int st = b / 1024, sb = b % 1024, swz = sb ^ (((sb >> 9) & 1) << 5); R = (st >> 1) * 16 + swz / 64; C = (st & 1) * 32 + (swz % 64) / 2; }
__host__ __device__ __forceinline__ int perm32(int rho) { const int n = rho >> 4, i = rho & 15; return 8 * (i >> 2) + 4 * n + (i & 3); }

struct Unit { int pm, pn, seg; };
struct Gemm { const bf16_t* A; const bf16_t* Bt; int K, lda, ldb, btile; };

struct StaticOrder {
    int nM, nN, nwg, G, c;
    __host__ __device__ void init(int M, int N, int G_, int c_) { nM = M / BM; nN = N / BM; nwg = nM * nN; G = G_; c = c_; }
    __host__ __device__ bool next(int i, Unit& u) const {
        const long L = (long)i * G + c; if (L >= nwg) return false;
        int wgid = (int)L; { const int q = nwg / NXCD, r = nwg % NXCD, xcd = wgid % NXCD, off = wgid / NXCD; wgid = (xcd < r ? xcd * (q + 1) : r * (q + 1) + (xcd - r) * q) + off; }
        const int nig = WGM * nN, gid = wgid / nig, fm = gid * WGM, gsz = (nM - fm) < WGM ? (nM - fm) : WGM;
        u.pm = fm + ((wgid % nig) % gsz); u.pn = (wgid % nig) / gsz; return true;
    }
    __device__ __forceinline__ int kt(const Unit&, int ntf) const { return ntf; }
    __device__ __forceinline__ size_t koff(const Unit&) const { return 0; }
    __device__ __forceinline__ void a_ready(const Unit&) const {}
    __device__ __forceinline__ void done(const Unit&) const {}
};

template <class Epi, class Sched, bool ALIGN_EPI = false, bool SP2 = false>
__device__ __forceinline__ void gemm_phase(PG8_LAS unsigned char* lds, const Gemm g, const Sched& S, const Epi& E) {
    const int tid = threadIdx.x, wid = __builtin_amdgcn_readfirstlane(tid >> 6), lane = tid & 63, wr = wid >> 2, wc = wid & 3, fr = lane & 15, fq = lane >> 4;
    const int ntf = g.K / BK;
    unsigned voffA[2], voffB[2];
#pragma unroll
    for (int i = 0; i < 2; ++i) { int R, C; stage_rc(tid * 16 + i * 8192, R, C); const int Rb = Epi::PERM ? ((R & ~31) + perm32(R & 31)) : R;
        voffA[i] = (unsigned)(R * g.lda + C) * 2u; voffB[i] = (unsigned)(Rb * g.ldb + C) * 2u; }
    const size_t kstep = (size_t)(BK * 2);
    const size_t hstepA = (size_t)HALF * g.lda * 2, hstepB = (size_t)HALF * g.ldb * 2;
    const size_t tstepA = 2 * hstepA, tstepB = (size_t)g.btile * g.ldb * 2;
    const unsigned ldsw = (unsigned)wid * 1024u;
    const int aoff = lds_byte(wr * 64 + fr, fq * 8), boff = lds_byte(wc * 32 + fr, fq * 8);
#define PG8_SA(b, h) (((b) * 2 + (h)) * HTB)
#define PG8_SB(b, h) ((4 + (b) * 2 + (h)) * HTB)
#define PG8_STAGE(bufoff, gbase, voff) do { _Pragma("unroll") for (int _i = 0; _i < 2; ++_i) \
        __builtin_amdgcn_global_load_lds((const unsigned*)((const char*)(gbase) + (voff)[_i]), (PG8_LAS unsigned*)(lds + (bufoff) + ldsw + _i * 8192), 16, 0, 0); } while (0)
#define PG8_LDA(dst, b, h) do { _Pragma("unroll") for (int m = 0; m < 4; ++m) _Pragma("unroll") for (int k = 0; k < 2; ++k) dst[m][k] = *(const PG8_LAS bf16x8*)(lds + PG8_SA(b, h) + aoff + m * 2048 + k * 1024); } while (0)
#define PG8_LDB(dst, b, h) do { _Pragma("unroll") for (int n = 0; n < 2; ++n) _Pragma("unroll") for (int k = 0; k < 2; ++k) dst[n][k] = *(const PG8_LAS bf16x8*)(lds + PG8_SB(b, h) + boff + n * 2048 + k * 1024); } while (0)
#define PG8_MMA(ai, bj, At, Bt) do { __builtin_amdgcn_s_setprio(1); _Pragma("unroll") for (int m = 0; m < 4; ++m) _Pragma("unroll") for (int n = 0; n < 2; ++n) _Pragma("unroll") for (int k = 0; k < 2; ++k) \
        acc[ai][bj][m][n] = __builtin_amdgcn_mfma_f32_16x16x32_bf16(Bt[n][k], At[m][k], acc[ai][bj][m][n], 0, 0, 0); __builtin_amdgcn_s_setprio(0); } while (0)
#define PG8_WAIT_V(n) asm volatile("s_waitcnt vmcnt(" #n ")" ::: "memory")
#define PG8_WAIT_L(n) asm volatile("s_waitcnt lgkmcnt(" #n ")" ::: "memory")
#define PG8_BAR __builtin_amdgcn_s_barrier()
#define PG8_SCHED __builtin_amdgcn_sched_barrier(0)
    Unit cur, nxt; int ui = 0;
    if (!S.next(0, cur)) return;
    f32x4 acc[2][2][4][2];
#pragma unroll
    for (int a = 0; a < 2; ++a)
#pragma unroll
        for (int b = 0; b < 2; ++b)
#pragma unroll
            for (int m = 0; m < 4; ++m)
#pragma unroll
                for (int n = 0; n < 2; ++n) acc[a][b][m][n] = (f32x4){0.f, 0.f, 0.f, 0.f};
    bf16x8 At[4][2], B0[2][2], B1[2][2];
    const char* cA = (const char*)g.A + (size_t)cur.pm * tstepA + S.koff(cur); const char* cB = (const char*)g.Bt + (size_t)cur.pn * tstepB + S.koff(cur);
    S.a_ready(cur);
    if constexpr (SP2) {
        PG8_STAGE(PG8_SB(0, 0), cB, voffB); PG8_STAGE(PG8_SB(0, 1), cB + hstepB, voffB); PG8_STAGE(PG8_SA(0, 0), cA, voffA); PG8_STAGE(PG8_SA(0, 1), cA + hstepA, voffA);
        if (wr == 1) PG8_BAR;
        PG8_WAIT_V(2); PG8_BAR;
        PG8_STAGE(PG8_SB(1, 0), cB + kstep, voffB); PG8_STAGE(PG8_SA(1, 0), cA + kstep, voffA); PG8_STAGE(PG8_SB(1, 1), cB + hstepB + kstep, voffB);
        PG8_WAIT_V(6); PG8_BAR;
    } else {
        PG8_STAGE(PG8_SB(0, 0), cB, voffB); PG8_STAGE(PG8_SA(0, 0), cA, voffA); PG8_STAGE(PG8_SB(0, 1), cB + hstepB, voffB); PG8_STAGE(PG8_SA(0, 1), cA + hstepA, voffA);
        if (wr == 1) PG8_BAR;
        PG8_WAIT_V(4); PG8_BAR;
        PG8_STAGE(PG8_SB(1, 0), cB + kstep, voffB); PG8_STAGE(PG8_SA(1, 0), cA + kstep, voffA); PG8_STAGE(PG8_SB(1, 1), cB + hstepB + kstep, voffB);
        PG8_WAIT_V(6); PG8_BAR;
    }
    for (;;) {
        const bool has_next = S.next(ui + 1, nxt);
        const char* nA = has_next ? (const char*)g.A + (size_t)nxt.pm * tstepA + S.koff(nxt) : cA; const char* nB = has_next ? (const char*)g.Bt + (size_t)nxt.pn * tstepB + S.koff(nxt) : cB;
        const int nt = S.kt(cur, ntf);
        for (int t = 0; t < nt; t += 2) {
            const bool last = (t == nt - 2);
            const char* a1 = cA + (size_t)(t + 1) * kstep;
            const char* a2 = last ? nA : cA + (size_t)(t + 2) * kstep; const char* b2 = last ? nB : cB + (size_t)(t + 2) * kstep;
            const char* a3 = a2 + kstep; const char* b3 = b2 + kstep;
            if (last && has_next) S.a_ready(nxt);
            if constexpr (SP2) {
            PG8_LDB(B0, 0, 0); PG8_LDB(B1, 0, 1); PG8_SCHED; PG8_LDA(At, 0, 0); PG8_STAGE(PG8_SA(1, 1), a1 + hstepA, voffA);
            PG8_WAIT_V(8); PG8_WAIT_L(0); PG8_BAR; PG8_MMA(0, 0, At, B0); PG8_MMA(0, 1, At, B1); PG8_BAR; PG8_SCHED;
            PG8_LDA(At, 0, 1); PG8_STAGE(PG8_SB(0, 0), b2, voffB); PG8_STAGE(PG8_SB(0, 1), b2 + hstepB, voffB); PG8_STAGE(PG8_SA(0, 0), a2, voffA);
            PG8_WAIT_V(8); PG8_WAIT_L(0); PG8_BAR; PG8_MMA(1, 0, At, B0); PG8_MMA(1, 1, At, B1); PG8_BAR; PG8_SCHED;
            PG8_LDB(B0, 1, 0); PG8_LDB(B1, 1, 1); PG8_SCHED; PG8_LDA(At, 1, 0); PG8_STAGE(PG8_SA(0, 1), a2 + hstepA, voffA);
            PG8_WAIT_V(8); PG8_WAIT_L(0); PG8_BAR; PG8_MMA(0, 0, At, B0); PG8_MMA(0, 1, At, B1); PG8_BAR; PG8_SCHED;
            PG8_LDA(At, 1, 1); PG8_STAGE(PG8_SB(1, 0), b3, voffB); PG8_STAGE(PG8_SB(1, 1), b3 + hstepB, voffB); PG8_STAGE(PG8_SA(1, 0), a3, voffA);
            PG8_WAIT_V(8); PG8_WAIT_L(0); PG8_BAR; PG8_MMA(1, 0, At, B0); PG8_MMA(1, 1, At, B1); PG8_BAR; PG8_SCHED;
            } else {
            PG8_LDB(B0, 0, 0); PG8_SCHED; PG8_LDA(At, 0, 0); PG8_STAGE(PG8_SA(1, 1), a1 + hstepA, voffA);
            PG8_WAIT_L(8); PG8_BAR; PG8_WAIT_L(0); PG8_MMA(0, 0, At, B0); PG8_BAR; PG8_SCHED;
            PG8_LDB(B1, 0, 1); PG8_STAGE(PG8_SB(0, 0), b2, voffB);
            PG8_BAR; PG8_WAIT_L(0); PG8_MMA(0, 1, At, B1); PG8_BAR;
            PG8_LDA(At, 0, 1); PG8_STAGE(PG8_SA(0, 0), a2, voffA);
            PG8_BAR; PG8_WAIT_L(0); PG8_MMA(1, 0, At, B0); PG8_BAR; PG8_SCHED;
            PG8_STAGE(PG8_SB(0, 1), b2 + hstepB, voffB);
            PG8_WAIT_V(6); PG8_BAR; PG8_MMA(1, 1, At, B1); PG8_BAR;
            PG8_LDB(B0, 1, 0); PG8_SCHED; PG8_LDA(At, 1, 0); PG8_STAGE(PG8_SA(0, 1), a2 + hstepA, voffA);
            PG8_WAIT_L(8); PG8_BAR; PG8_WAIT_L(0); PG8_MMA(0, 0, At, B0); PG8_BAR; PG8_SCHED;
            PG8_LDB(B1, 1, 1); PG8_STAGE(PG8_SB(1, 0), b3, voffB);
            PG8_BAR; PG8_WAIT_L(0); PG8_MMA(0, 1, At, B1); PG8_BAR;
            PG8_LDA(At, 1, 1); PG8_STAGE(PG8_SA(1, 0), a3, voffA);
            PG8_BAR; PG8_WAIT_L(0); PG8_MMA(1, 0, At, B0); PG8_BAR; PG8_SCHED;
            PG8_STAGE(PG8_SB(1, 1), b3 + hstepB, voffB);
            PG8_WAIT_V(6); PG8_BAR; PG8_MMA(1, 1, At, B1); PG8_BAR;
            }
        }
        if constexpr (ALIGN_EPI) { if (wr == 0) PG8_BAR; }
        bool part_ = false; if constexpr (Epi::HAS_MID) part_ = S.partial(cur);
        if constexpr (!Epi::AFTER_DRAIN) { if constexpr (Epi::HAS_MID) { if (part_) E.mid(acc, cur, wr, wc, fr, fq); else E(acc, cur, wr, wc, fr, fq); } else E(acc, cur, wr, wc, fr, fq); S.done(cur); }
        if (!has_next) break;
        if (!part_)
#pragma unroll
        for (int a = 0; a < 2; ++a)
#pragma unroll
            for (int b = 0; b < 2; ++b)
#pragma unroll
                for (int m = 0; m < 4; ++m)
#pragma unroll
                    for (int n = 0; n < 2; ++n) acc[a][b][m][n] = (f32x4){0.f, 0.f, 0.f, 0.f};
        cur = nxt; cA = nA; cB = nB; ++ui;
        if constexpr (ALIGN_EPI) { if (wr == 1) PG8_BAR; }
    }
    PG8_WAIT_V(0);
    if constexpr (!ALIGN_EPI) { if (wr == 0) PG8_BAR; }
    PG8_BAR;
    if constexpr (Epi::AFTER_DRAIN) { E.fused(acc, cur, wr, wc, fr, fq, lds, wid, lane); S.done(cur); }
#undef PG8_SA
#undef PG8_SB
#undef PG8_STAGE
#undef PG8_LDA
#undef PG8_LDB
#undef PG8_MMA
#undef PG8_WAIT_V
#undef PG8_WAIT_L
#undef PG8_BAR
#undef PG8_SCHED
}
}
namespace pg8 {
DI u32x4 pack8(f32x4 v0, f32x4 v1) { u32x4 w; w.x = pkbf(v0[0], v0[1]); w.y = pkbf(v0[2], v0[3]); w.z = pkbf(v1[0], v1[1]); w.w = pkbf(v1[2], v1[3]); return w; }
DI f32x4 sig4(f32x4 v) { f32x4 o; o[0] = sigmoid_f(v[0]); o[1] = sigmoid_f(v[1]); o[2] = sigmoid_f(v[2]); o[3] = sigmoid_f(v[3]); return o; }
DI float gelu_tanh(float x) { const float t = 1.5957691216f * (x + 0.044715f * x * x * x); return x * sigmoid_f(t); }
DI f32x4 gelu4(f32x4 v) { f32x4 o; o[0] = gelu_tanh(v[0]); o[1] = gelu_tanh(v[1]); o[2] = gelu_tanh(v[2]); o[3] = gelu_tanh(v[3]); return o; }
#define EPI_ROWS for (int ai = 0; ai < 2; ++ai) _Pragma("unroll") for (int m = 0; m < 4; ++m)

struct EpiIn {
    static constexpr bool PERM = true, AFTER_DRAIN = false, HAS_MID = false;
    bf16_t *Q, *Kb, *VT, *UC, *GATES; const float* b_gate;
    DI void operator()(const f32x4 (&acc)[2][2][4][2], const Unit& u, int wr, int wc, int fr, int fq) const {
        const int pn = u.pn, rbase = u.pm * BM + wr * 64 + fr, cb = wc * 32 + 8 * fq;
        if (pn < 4) {
            bf16_t* dst = pn < 2 ? Q : Kb; const float sc = pn < 2 ? 0.125f * 1.4426950408889634f : 1.0f;   const int c0 = (pn & 1) * 256 + cb;
#pragma unroll
            EPI_ROWS { const int row = rbase + ai * HALF + m * 16;
#pragma unroll
                for (int bj = 0; bj < 2; ++bj) *(u32x4*)(dst + (size_t)row * 512 + c0 + bj * HALF) = pack8(acc[ai][bj][m][0] * sc, acc[ai][bj][m][1] * sc); }
        } else if (pn < 6) {
#pragma unroll
            EPI_ROWS { const int row = rbase + ai * HALF + m * 16, b = row >> 12, s = row & 4095;
#pragma unroll
                for (int bj = 0; bj < 2; ++bj) { const int cv = (pn - 4) * 256 + bj * HALF + cb, h = cv >> 6, d = cv & 63;
                    bf16_t* p = VT + ((size_t)((b * 8 + h) * 64 + d)) * 4096 + s; const u32x4 w = pack8(acc[ai][bj][m][0] * 1.0f, acc[ai][bj][m][1] * 1.0f);
                    p[0] = (bf16_t)(w.x & 0xffffu); p[4096] = (bf16_t)(w.x >> 16); p[2 * 4096] = (bf16_t)(w.y & 0xffffu); p[3 * 4096] = (bf16_t)(w.y >> 16);
                    p[4 * 4096] = (bf16_t)(w.z & 0xffffu); p[5 * 4096] = (bf16_t)(w.z >> 16); p[6 * 4096] = (bf16_t)(w.w & 0xffffu); p[7 * 4096] = (bf16_t)(w.w >> 16); } }
        } else if (pn < 8) {
#pragma unroll
            EPI_ROWS { const int row = rbase + ai * HALF + m * 16, bc = row >> 6, j = row & 63;
#pragma unroll
                for (int bj = 0; bj < 2; ++bj) { const int cu = (pn - 6) * 256 + bj * HALF + cb, g = cu >> 4, hh = cu & 15;
                    *(u32x4*)(UC + ((size_t)(g * 1024 + bc)) * 1152 + 128 + j * 16 + hh) = pack8(acc[ai][bj][m][0] * 1.0f, acc[ai][bj][m][1] * 1.0f); } }
        } else {
#pragma unroll
            for (int bj = 0; bj < 2; ++bj) { const int cgt = (pn - 8) * 256 + bj * HALF + cb; const f32x4 b0 = *(const f32x4*)(b_gate + cgt), b1 = *(const f32x4*)(b_gate + cgt + 4);
#pragma unroll
                EPI_ROWS { const int row = rbase + ai * HALF + m * 16;
                    const f32x4 s0 = sig4(acc[ai][bj][m][0] + b0), s1 = sig4(acc[ai][bj][m][1] + b1);
                    *(u32x2*)((unsigned char*)GATES + (size_t)row * 2048 + cgt) = (u32x2){pk4u8(s0[0], s0[1], s0[2], s0[3]), pk4u8(s1[0], s1[1], s1[2], s1[3])}; } }
        }
    }
};
struct EpiSend {
    static constexpr bool PERM = true, AFTER_DRAIN = false, HAS_MID = false;
    float* SEND;
    DI void operator()(const f32x4 (&acc)[2][2][4][2], const Unit& u, int wr, int wc, int fr, int fq) const {
        const int g = u.pm >> 2, rbase = (u.pm & 3) * BM + wr * 64 + fr, c = wc * 32 + 8 * fq;
#pragma unroll
        EPI_ROWS { const int bc = rbase + ai * HALF + m * 16; float* p = SEND + ((size_t)bc * 32 + g) * 128 + c; *(f32x4*)p = acc[ai][0][m][0]; *(f32x4*)(p + 4) = acc[ai][0][m][1]; }
    }
};
struct EpiSsmOut {
    static constexpr bool PERM = true, AFTER_DRAIN = false, HAS_MID = false;
    bf16_t* YS;
    DI void operator()(const f32x4 (&acc)[2][2][4][2], const Unit& u, int wr, int wc, int fr, int fq) const {
        const int g = u.pm >> 2, rbase = (u.pm & 3) * BM + wr * 64 + fr, cb = (u.pn & 3) * BM + wc * 32 + 8 * fq;
#pragma unroll
        EPI_ROWS { const int bc = rbase + ai * HALF + m * 16;
#pragma unroll
            for (int bj = 0; bj < 2; ++bj) { const int n = cb + bj * HALF, i = n >> 4, h0 = n & 15;
                *(u32x4*)(YS + ((size_t)bc * 64 + i) * 512 + g * 16 + h0) = pack8(gelu4(acc[ai][bj][m][0]), gelu4(acc[ai][bj][m][1])); } }
    }
};
struct EpiGlu {
    static constexpr bool PERM = true, AFTER_DRAIN = false, HAS_MID = false;
    bf16_t* GLU;
    DI void operator()(const f32x4 (&acc)[2][2][4][2], const Unit& u, int wr, int wc, int fr, int fq) const {
        const int rbase = u.pm * BM + wr * 64 + fr, col = u.pn * HALF + wc * 32 + 8 * fq;
#pragma unroll
        EPI_ROWS { const int row = rbase + ai * HALF + m * 16;
            *(u32x4*)(GLU + (size_t)row * 1024 + 512 + col) = pack8(acc[ai][0][m][0] * sig4(acc[ai][1][m][0]), acc[ai][0][m][1] * sig4(acc[ai][1][m][1])); }
    }
};
struct EpiMix {
    static constexpr bool PERM = true, AFTER_DRAIN = false, HAS_MID = true;
    const bf16_t* GATES; bf16_t* MIXED;
    DI void mid(f32x4 (&acc)[2][2][4][2], const Unit& u, int wr, int wc, int fr, int fq) const {
        const unsigned char* gp = (const unsigned char*)GATES + (size_t)(u.pm * BM + wr * 64 + fr) * 2048 + u.pn * BM + wc * 32 + 8 * fq;
#pragma unroll
        EPI_ROWS {
#pragma unroll
            for (int bj = 0; bj < 2; ++bj) { const unsigned char* q = gp + (size_t)(ai * HALF + m * 16) * 2048 + bj * HALF; const u32x2 ga = *(const u32x2*)q, gb = *(const u32x2*)(q + 1024);
                f32x4 r0, r1;
#pragma unroll
                for (int e = 0; e < 4; ++e) { r0[e] = u8f(ga.x, e) * __builtin_amdgcn_rcpf(fmaxf(u8f(gb.x, e), 1e-18f)); r1[e] = u8f(ga.y, e) * __builtin_amdgcn_rcpf(fmaxf(u8f(gb.y, e), 1e-18f)); }
                acc[ai][bj][m][0] *= r0; acc[ai][bj][m][1] *= r1; }
            asm volatile("" ::: "memory"); }
    }
    DI void operator()(const f32x4 (&acc)[2][2][4][2], const Unit& u, int wr, int wc, int fr, int fq) const {
        const int rbase = u.pm * BM + wr * 64 + fr, cb = u.pn * BM + wc * 32 + 8 * fq;
#pragma unroll
        EPI_ROWS { const int row = rbase + ai * HALF + m * 16;
#pragma unroll
            for (int bj = 0; bj < 2; ++bj) { const int c = cb + bj * HALF; const u32x2 gb = *(const u32x2*)((const unsigned char*)GATES + (size_t)row * 2048 + 1024 + c);
                f32x4 b0, b1;
#pragma unroll
                for (int e = 0; e < 4; ++e) { b0[e] = fmaxf(u8f(gb.x, e), 1e-18f) * (1.0f / 255.0f); b1[e] = fmaxf(u8f(gb.y, e), 1e-18f) * (1.0f / 255.0f); }
                *(u32x4*)(MIXED + (size_t)row * 1024 + c) = pack8(acc[ai][bj][m][0] * b0, acc[ai][bj][m][1] * b1); } }
    }
};
template <bool BASE_BF16> struct EpiResid {
    static constexpr bool PERM = true, AFTER_DRAIN = false, HAS_MID = false;
    const float* basef; const bf16_t* baseb; bf16_t* HB; float* rowss;
    DI void operator()(const f32x4 (&acc)[2][2][4][2], const Unit& u, int wr, int wc, int fr, int fq) const {
        const int rbase = u.pm * BM + wr * 64 + fr, cb = u.pn * BM + wc * 32 + 8 * fq;
#pragma unroll
        EPI_ROWS { const int row = rbase + ai * HALF + m * 16; float ss = 0.f;
#pragma unroll
            for (int bj = 0; bj < 2; ++bj) { const size_t off = (size_t)row * 1024 + cb + bj * HALF; f32x4 b0, b1;
                if (BASE_BF16) { const u32x4 bw = *(const u32x4*)(baseb + off); b0 = (f32x4){bf_lo(bw.x), bf_hi(bw.x), bf_lo(bw.y), bf_hi(bw.y)}; b1 = (f32x4){bf_lo(bw.z), bf_hi(bw.z), bf_lo(bw.w), bf_hi(bw.w)}; }
                else { b0 = *(const f32x4*)(basef + off); b1 = *(const f32x4*)(basef + off + 4); }
                const f32x4 h0 = b0 + acc[ai][bj][m][0], h1 = b1 + acc[ai][bj][m][1];
                *(u32x4*)(HB + off) = pack8(h0, h1);
                ss += (h0[0] * h0[0] + h0[1] * h0[1]) + (h0[2] * h0[2] + h0[3] * h0[3]) + (h1[0] * h1[0] + h1[1] * h1[1]) + (h1[2] * h1[2] + h1[3] * h1[3]); }
            ss += __shfl_xor(ss, 16); ss += __shfl_xor(ss, 32);
            if (fq == 0) unsafeAtomicAdd(rowss + row, ss); }
    }
};
struct EpiFF1 {
    static constexpr bool PERM = true, AFTER_DRAIN = false, HAS_MID = false;
    const float* rowss; bf16_t* HID;
    DI void operator()(const f32x4 (&acc)[2][2][4][2], const Unit& u, int wr, int wc, int fr, int fq) const {
        const int rbase = u.pm * BM + wr * 64 + fr, cb = u.pn * BM + wc * 32 + 8 * fq;
#pragma unroll
        EPI_ROWS { const int row = rbase + ai * HALF + m * 16; const float rs = __builtin_amdgcn_rsqf(rowss[row] * (1.0f / 1024.0f) + 1e-6f);
#pragma unroll
            for (int bj = 0; bj < 2; ++bj) { f32x4 t0 = acc[ai][bj][m][0] * rs, t1 = acc[ai][bj][m][1] * rs;
                t0 = __builtin_elementwise_max(t0, (f32x4){0.f, 0.f, 0.f, 0.f}); t1 = __builtin_elementwise_max(t1, (f32x4){0.f, 0.f, 0.f, 0.f});
                *(u32x4*)(HID + (size_t)row * 4096 + cb + bj * HALF) = pack8(t0 * t0, t1 * t1); } }
    }
};
struct EndOrder {
    int G, c;
    DI bool next(int i, Unit& u) const { const int L = i * G + c; if (L >= 128) return false; u.pm = L; u.pn = L >> 2; return true; }
    DI int kt(const Unit&, int ntf) const { return ntf; }
    DI size_t koff(const Unit&) const { return 0; }
    DI void a_ready(const Unit&) const {}
    DI void done(const Unit&) const {}
};
struct OutOrder {
    int G, c;
    DI bool next(int i, Unit& u) const { const int P = (i >> 1) * G + c; if (P >= 256) return false; const int g = P >> 3, pmq = (P & 7) >> 1, a = P & 1, pnq = (i & 1) ? a : 3 - a; u.pm = g * 4 + pmq; u.pn = g * 4 + pnq; return true; }
    DI int kt(const Unit& u, int) const { return 2 + 4 * ((u.pn & 3) + 1); }
    DI size_t koff(const Unit&) const { return 0; }
    DI void a_ready(const Unit&) const {}
    DI void done(const Unit&) const {}
};
struct MixOrder {
    StaticOrder B;
    DI bool next(int i, Unit& u) const { if (!B.next(i >> 1, u)) return false; u.seg = i & 1; return true; }
    DI int kt(const Unit&, int) const { return 8; }
    DI size_t koff(const Unit& u) const { return (size_t)u.seg * 1024; }
    DI bool partial(const Unit& u) const { return u.seg == 0; }
    DI void a_ready(const Unit&) const {}
    DI void done(const Unit&) const {}
};
}
using pg8::bf16_t; using pg8::bf16x8; using pg8::f32x4; using pg8::u32x4;
#define LAS __attribute__((address_space(3)))
constexpr int TOK = 65536, DM = 1024, SEQ = 4096, NCH = 64, NBC = 1024;
constexpr size_t MiB = 1u << 20;
constexpr size_t WS_ROWSS1 = 0, WS_ROWSS2 = 256 * 1024;
constexpr size_t WS_BAR = 512 * 1024, BAR_BYTES = 16384 + 256, WS_QCTR = WS_BAR + 14336, WS_PCNT = WS_BAR + 16384;
constexpr size_t WS_WIN = 1 * MiB, WS_WGLU = 9 * MiB, WS_WAB = 10 * MiB, WS_WOUT = 12 * MiB, WS_WFF1 = 14 * MiB, WS_WFF2 = 22 * MiB;
constexpr size_t WS_MCAT = 30 * MiB;
constexpr size_t WS_WEND = 102 * MiB;
constexpr size_t WS_SEND = 111 * MiB;
constexpr size_t WS_UC = 128 * MiB;
constexpr size_t WS_XN = 200 * MiB;
constexpr size_t WS_MIXED = 328 * MiB;
constexpr size_t WS_Q = 328 * MiB;
constexpr size_t WS_K = 392 * MiB;
constexpr size_t WS_VT = 456 * MiB;
constexpr size_t WS_GATES = 520 * MiB;
constexpr size_t WS_HB = 776 * MiB;
constexpr size_t WS_HID = 264 * MiB;
constexpr size_t WS_ATT = 904 * MiB;
constexpr size_t WS_H2B = 128 * MiB;
constexpr size_t WS_END = 968 * MiB;
constexpr int LDS_BYTES = 147456;
constexpr float LOG2E = 1.4426950408889634f;

struct Args { const float* in[21]; float* out; unsigned char* ws; int ph_lo, ph_hi; };

DI float wave_sum(float v) {
#pragma unroll
    for (int o = 1; o < 64; o <<= 1) v += __shfl_xor(v, o);
    return v;
}
DI void transpose_item(const float* W, int K, int N, bf16_t* WT, const float* sc, LAS float* scr, int k0, int n0, int sn0, int lane) {
    float wv[32];
#pragma unroll
    for (int i = 0; i < 32; ++i) wv[i] = W[(size_t)(k0 + 2 * i + (lane >> 5)) * N + sn0 + (lane & 31)];
#pragma unroll
    for (int i = 0; i < 32; ++i) { const int kk = 2 * i + (lane >> 5); float v = wv[i]; if (sc) v *= sc[k0 + kk]; scr[kk * 33 + (lane & 31)] = v; }
    asm volatile("s_waitcnt lgkmcnt(0)" ::: "memory");
    const int c = lane & 7;
#pragma unroll
    for (int j = 0; j < 4; ++j) { const int n = (lane >> 3) + 8 * j; const LAS float* s = scr + (8 * c) * 33 + n;
        u32x4 o; o.x = pkbf(s[0 * 33], s[1 * 33]); o.y = pkbf(s[2 * 33], s[3 * 33]); o.z = pkbf(s[4 * 33], s[5 * 33]); o.w = pkbf(s[6 * 33], s[7 * 33]);
        *(u32x4*)(WT + (size_t)(n0 + n) * K + k0 + 8 * c) = o; }
    asm volatile("s_waitcnt lgkmcnt(0)" ::: "memory");
}
constexpr int SL = 130;
DI void ssm_precompute(LAS unsigned char* lds, const Args& a, unsigned char* ws, int blk, int tid) {
    const int g = blk >> 2, r = blk & 3;
    LAS float* L = (LAS float*)lds; LAS float* Cc = L + 65 * SL + 2;     LAS float* Bb = Cc + 16 * SL; LAS bf16_t* KtR = (LAS bf16_t*)(Bb + 2048);
    const float *a_re = a.in[5], *a_im = a.in[6], *log_dt = a.in[7], *b_re = a.in[8], *b_im = a.in[9], *c_re = a.in[10], *c_im = a.in[11], *dsk = a.in[12];
    const double dt = exp((double)log_dt[g]);
    if (tid < 64) { const int p = tid; const double zr = (double)a_re[g * 64 + p] * dt, zi = (double)a_im[g * 64 + p] * dt;
        double s, c; sincos(zi, &s, &c); const double e = exp(zr); const double lr = e * c, li = e * s; double pr = 1.0, pi_ = 0.0;
        for (int d = 0; d < 65; ++d) { L[d * SL + p * 2] = (float)pr; L[d * SL + p * 2 + 1] = (float)pi_; const double nr = pr * lr - pi_ * li; pi_ = pr * li + pi_ * lr; pr = nr; } }
    for (int idx = tid; idx < 1024; idx += 512) { const int p = idx >> 4; const double ar = a_re[g * 64 + p], ai = a_im[g * 64 + p]; const double zr = ar * dt, zi = ai * dt;
        double s, c; sincos(zi, &s, &c); const double e = exp(zr); const double nr = e * c - 1.0, ni = e * s, den = ar * ar + ai * ai;
        const double qr = (nr * ar + ni * ai) / den, qi = (ni * ar - nr * ai) / den;
        const double br = b_re[g * 1024 + idx], bi = b_im[g * 1024 + idx];
        Bb[idx * 2] = (float)(qr * br - qi * bi); Bb[idx * 2 + 1] = (float)(qr * bi + qi * br);
        const int ch = idx >> 6, cp = idx & 63;
        Cc[ch * SL + cp * 2] = c_re[g * 1024 + idx]; Cc[ch * SL + cp * 2 + 1] = c_im[g * 1024 + idx]; }
    __syncthreads();
    {
        const int h = tid & 15, d0 = tid >> 4, d1 = d0 + 32;
        float acc0[16], acc1[16];
#pragma unroll
        for (int e = 0; e < 16; ++e) { acc0[e] = 0.f; acc1[e] = 0.f; }
        for (int p = 0; p < 64; ++p) { const f32x2 cv = *(const LAS f32x2*)(Cc + h * SL + p * 2), l0 = *(const LAS f32x2*)(L + d0 * SL + p * 2), l1 = *(const LAS f32x2*)(L + d1 * SL + p * 2);
            const float w0r = cv[0] * l0[0] - cv[1] * l0[1], w0i = cv[0] * l0[1] + cv[1] * l0[0], w1r = cv[0] * l1[0] - cv[1] * l1[1], w1i = cv[0] * l1[1] + cv[1] * l1[0];
            const LAS f32x4* bp = (const LAS f32x4*)(Bb + p * 32);
#pragma unroll
            for (int e2 = 0; e2 < 8; ++e2) { const f32x4 bb = bp[e2];
                acc0[2 * e2] += w0r * bb[0] - w0i * bb[1]; acc0[2 * e2 + 1] += w0r * bb[2] - w0i * bb[3];
                acc1[2 * e2] += w1r * bb[0] - w1i * bb[1]; acc1[2 * e2 + 1] += w1r * bb[2] - w1i * bb[3]; } }
        if (d0 == 0) {
#pragma unroll
            for (int e = 0; e < 16; ++e) if (e == h) acc0[e] += dsk[g * 16 + h]; }
        u32x4 w0a, w0b, w1a, w1b;
        w0a.x = pkbf(acc0[0], acc0[1]); w0a.y = pkbf(acc0[2], acc0[3]); w0a.z = pkbf(acc0[4], acc0[5]); w0a.w = pkbf(acc0[6], acc0[7]);
        w0b.x = pkbf(acc0[8], acc0[9]); w0b.y = pkbf(acc0[10], acc0[11]); w0b.z = pkbf(acc0[12], acc0[13]); w0b.w = pkbf(acc0[14], acc0[15]);
        w1a.x = pkbf(acc1[0], acc1[1]); w1a.y = pkbf(acc1[2], acc1[3]); w1a.z = pkbf(acc1[4], acc1[5]); w1a.w = pkbf(acc1[6], acc1[7]);
        w1b.x = pkbf(acc1[8], acc1[9]); w1b.y = pkbf(acc1[10], acc1[11]); w1b.z = pkbf(acc1[12], acc1[13]); w1b.w = pkbf(acc1[14], acc1[15]);
        LAS u32x4* k0 = (LAS u32x4*)(KtR + (h * 64 + 63 - d0) * 16); LAS u32x4* k1 = (LAS u32x4*)(KtR + (h * 64 + 63 - d1) * 16);
        k0[0] = w0a; k0[1] = w0b; k1[0] = w1a; k1[1] = w1b;
    }
    __syncthreads();
    bf16_t* Mg = (bf16_t*)(ws + WS_MCAT) + (size_t)g * 1024 * 1152;
    for (int idx = tid; idx < 256 * 128; idx += 512) { const int rl = idx >> 7, qt = idx & 127, n = r * 256 + rl, i = n >> 4, h = n & 15;
        u32x4 w = {0u, 0u, 0u, 0u};
        if ((qt >> 1) <= i) w = *(const LAS u32x4*)(KtR + (h * 64 + 63 - i) * 16 + qt * 8);
        *(u32x4*)(Mg + (size_t)n * 1152 + 128 + qt * 8) = w; }
    for (int idx = tid; idx < 256 * 64; idx += 512) { const int rl = idx >> 6, pp = idx & 63, n = r * 256 + rl, i = n >> 4, h = n & 15, p = (2 * pp) & 63; const bool im = pp >= 32;
        const f32x2 c0 = *(const LAS f32x2*)(Cc + h * SL + p * 2), c1 = *(const LAS f32x2*)(Cc + h * SL + p * 2 + 2), l0 = *(const LAS f32x2*)(L + (i + 1) * SL + p * 2), l1 = *(const LAS f32x2*)(L + (i + 1) * SL + p * 2 + 2);
        const float v0 = im ? -(c0[0] * l0[1] + c0[1] * l0[0]) : (c0[0] * l0[0] - c0[1] * l0[1]), v1 = im ? -(c1[0] * l1[1] + c1[1] * l1[0]) : (c1[0] * l1[0] - c1[1] * l1[1]);
        *(unsigned*)(Mg + (size_t)n * 1152 + 2 * pp) = pkbf(v0, v1); }
    bf16_t* Wg = (bf16_t*)(ws + WS_WEND) + (size_t)g * 128 * 1024;
    for (int idx = tid; idx < 32 * 128; idx += 512) { const int rl = idx >> 7, q = idx & 127, n = r * 32 + rl, p = n & 63, j = q >> 1, h0 = (q & 1) * 8; const bool im = n >= 64;
        const float lr = L[(63 - j) * SL + p * 2], li = L[(63 - j) * SL + p * 2 + 1]; f32x4 v0, v1;
#pragma unroll
        for (int e = 0; e < 8; ++e) { const float br = Bb[(p * 16 + h0 + e) * 2], bi = Bb[(p * 16 + h0 + e) * 2 + 1]; const float val = im ? (lr * bi + li * br) : (lr * br - li * bi); if (e < 4) v0[e] = val; else v1[e - 4] = val; }
        *(u32x4*)(Wg + (size_t)n * 1024 + q * 8) = pg8::pack8(v0, v1); }
    __syncthreads();
}
DI void prologue(LAS unsigned char* lds, const Args& a, unsigned char* ws, int blk, int G, int tid) {
    const int lane = tid & 63, wave = tid >> 6;
    float* rss = (float*)(ws + WS_ROWSS1);
    for (int i = blk * 512 + tid; i < 2 * TOK; i += G * 512) rss[i] = 0.f;
    for (int sb = blk; sb < 128; sb += G) ssm_precompute(lds, a, ws, sb, tid);
    LAS float* scr = (LAS float*)(lds + wave * 16384);
    constexpr int I_IN = 16 * 128, I_GLU = 8 * 32, I_A = 8 * 32, I_B = 8 * 32, I_OUT = 16 * 32, I_F1 = 16 * 128, I_F2 = 64 * 32;
    constexpr int NITEMS = I_IN + I_GLU + I_A + I_B + I_OUT + I_F1 + I_F2, NXN = TOK / 16;
    unsigned* qctr = (unsigned*)(ws + WS_QCTR);
    const float* x = a.in[0]; const f32x4* gm = (const f32x4*)a.in[1] + lane; bf16_t* XN = (bf16_t*)(ws + WS_XN);
    int shard_i = 0;
    for (;;) {
        const int shard = (blk + shard_i) & 7;
        int it = 0; if (lane == 0) it = (int)__hip_atomic_fetch_add(qctr + shard * 64, 1u, __ATOMIC_RELAXED, __HIP_MEMORY_SCOPE_AGENT);
        it = __builtin_amdgcn_readfirstlane(it) * 8 + shard;
        if (it >= NITEMS + NXN) { if (++shard_i == 8) break; continue; }
        if (it >= NITEMS) {
            const int m0 = (it - NITEMS) * 16;
            f32x4 gv[4];
#pragma unroll
            for (int j = 0; j < 4; ++j) gv[j] = gm[64 * j];
            for (int mb = m0; mb < m0 + 16; mb += 4) {
                f32x4 v[4][4];
#pragma unroll
                for (int r = 0; r < 4; ++r) { const f32x4* xr = (const f32x4*)(x + (size_t)(mb + r) * DM) + lane;
#pragma unroll
                    for (int j = 0; j < 4; ++j) v[r][j] = xr[64 * j]; }
#pragma unroll
                for (int r = 0; r < 4; ++r) { float s = 0.f;
#pragma unroll
                    for (int j = 0; j < 4; ++j) s += (v[r][j][0] * v[r][j][0] + v[r][j][1] * v[r][j][1]) + (v[r][j][2] * v[r][j][2] + v[r][j][3] * v[r][j][3]);
                    const float rs = 1.0f / sqrtf(wave_sum(s) * (1.0f / DM) + 1e-6f);
                    u32x2* o8 = (u32x2*)(XN + (size_t)(mb + r) * DM) + lane;
#pragma unroll
                    for (int j = 0; j < 4; ++j) { const f32x4 t = v[r][j] * rs * gv[j]; u32x2 w; w.x = pkbf(t[0], t[1]); w.y = pkbf(t[2], t[3]); o8[64 * j] = w; } } }
            continue;
        }
        int rr = it;
        if (rr < I_IN) { transpose_item(a.in[2], 1024, 4096, (bf16_t*)(ws + WS_WIN), nullptr, scr, 64 * (rr / 128), 32 * (rr % 128), 32 * (rr % 128), lane); continue; } rr -= I_IN;
        if (rr < I_GLU) { const int n0 = 32 * (rr % 32), sn0 = ((n0 & 255) >> 7) * 512 + 128 * (n0 >> 8) + (n0 & 127);
            transpose_item(a.in[13], 512, 1024, (bf16_t*)(ws + WS_WGLU), nullptr, scr, 64 * (rr / 32), n0, sn0, lane); continue; } rr -= I_GLU;
        if (rr < I_A) { transpose_item(a.in[14], 1024, 1024, (bf16_t*)(ws + WS_WAB), nullptr, scr, 64 * (rr / 32), 32 * (rr % 32), 32 * (rr % 32), lane); continue; } rr -= I_A;
        if (rr < I_B) { transpose_item(a.in[15], 1024, 1024, (bf16_t*)(ws + WS_WAB) + 512, nullptr, scr, 64 * (rr / 32), 32 * (rr % 32), 32 * (rr % 32), lane); continue; } rr -= I_B;
        if (rr < I_OUT) { transpose_item(a.in[16], 1024, 1024, (bf16_t*)(ws + WS_WOUT), nullptr, scr, 64 * (rr / 32), 32 * (rr % 32), 32 * (rr % 32), lane); continue; } rr -= I_OUT;
        if (rr < I_F1) { transpose_item(a.in[18], 1024, 4096, (bf16_t*)(ws + WS_WFF1), a.in[17], scr, 64 * (rr / 128), 32 * (rr % 128), 32 * (rr % 128), lane); continue; } rr -= I_F1;
        transpose_item(a.in[19], 4096, 1024, (bf16_t*)(ws + WS_WFF2), nullptr, scr, 64 * (rr / 32), 32 * (rr % 32), 32 * (rr % 32), lane);
    }
    __syncthreads();
}
#define MFMA32(a, b, c) __builtin_amdgcn_mfma_f32_32x32x16_bf16((a), (b), (c), 0, 0, 0)
DI int crow(int reg, int hh) { return (reg & 3) + 8 * (reg >> 2) + 4 * hh; }
constexpr int AT_KROW = 144, AT_VROW = 136, AT_KBUF = 64 * AT_KROW, AT_VBUF = 64 * AT_VROW, AT_SEL = AT_KBUF + AT_VBUF, AT_PAR = 2 * AT_SEL, AT_BIAS = 2 * AT_PAR, AT_UQ = AT_BIAS + 2048, AT_TILES = 77824;
DI float max16(const f32x16& S) { float m = fmaxf(S[0], S[1]);
#pragma unroll
    for (int e = 2; e < 16; e += 2) m = fmaxf(fmaxf(m, S[e]), S[e + 1]);
    return m; }
DI float exp_sum16(f32x16& S) { f32x2 a = {0.f, 0.f};
#pragma unroll
    for (int e = 0; e < 16; e += 2) { S[e] = __builtin_amdgcn_exp2f(S[e]); S[e + 1] = __builtin_amdgcn_exp2f(S[e + 1]); a += (f32x2){S[e], S[e + 1]}; }
    return a[0] + a[1]; }
DI bf16x8 pack_half(const f32x16& S, int s2) { u32x4 pw; pw.x = pkbf(S[8 * s2], S[8 * s2 + 1]); pw.y = pkbf(S[8 * s2 + 2], S[8 * s2 + 3]); pw.z = pkbf(S[8 * s2 + 4], S[8 * s2 + 5]); pw.w = pkbf(S[8 * s2 + 6], S[8 * s2 + 7]); return __builtin_bit_cast(bf16x8, pw); }
DI void attn_phase(LAS unsigned char* lds, const bf16_t* Q, bf16_t* ATT, const bf16_t* Kb, const bf16_t* VT, const float* rel_bias, unsigned* actr, int tid) {
    const int wave = tid >> 6, lane = tid & 63, c32 = lane & 31, hh = lane >> 5, sel = wave >> 2;
    LAS float* bt = (LAS float*)(lds + AT_BIAS); volatile LAS int* uq = (volatile LAS int*)(lds + AT_UQ);
    const int ssel = tid >> 8, srow = (tid & 255) >> 3, spc = tid & 7;
    __syncthreads();
    if (tid == 0) uq[0] = (int)__hip_atomic_fetch_add(actr, 1u, __ATOMIC_RELAXED, __HIP_MEMORY_SCOPE_AGENT);
    __syncthreads();
    int cur = uq[0];
    while (cur < 1024) {
        int nxt_ticket = 0;
        if (tid == 0) nxt_ticket = (int)__hip_atomic_fetch_add(actr, 1u, __ATOMIC_RELAXED, __HIP_MEMORY_SCOPE_AGENT);
        const int rank = cur >> 6, bp = (cur & 63) >> 3, h = cur & 7, gidx = rank < 14 ? rank + 2 : 15 - rank, n0 = gidx * 4;
        if (tid < 257) bt[tid] = rel_bias[h * 257 + tid] * LOG2E;
        __syncthreads();
        {
            LAS float* BT = (LAS float*)(lds + AT_TILES);
            for (int idx = tid; idx < 7 * 1024; idx += 512) { const int t = idx >> 10, q = (idx >> 8) & 3, ln = (idx >> 2) & 63, r = idx & 3;
                int id = 32 * t - 32 + (ln & 31) - crow(4 * q + r, ln >> 5) + 128; id = id < 0 ? 0 : (id > 256 ? 256 : id); BT[idx] = bt[id]; }
        }
        const int bw = bp + 8 * sel, bs = bp + 8 * ssel, n = n0 + (wave & 3);
        const bf16_t* kg = Kb + ((size_t)bs * SEQ + srow) * 512 + h * 64 + spc * 8;
        const bf16_t* vg = VT + ((size_t)((bs * 8 + h) * 64 + srow)) * 4096 + spc * 8;
        const int kc_lo = n0 >= 8 ? n0 - 8 : 0, kc_hi = n0 + 3;
        const size_t tok0 = (size_t)bw * SEQ + n * 64 + c32;
        bf16x8 qf0[4], qf1[4];
#pragma unroll
        for (int s = 0; s < 4; ++s) { qf0[s] = *(const bf16x8*)(Q + tok0 * 512 + h * 64 + 32 * hh + 8 * s); qf1[s] = *(const bf16x8*)(Q + (tok0 + 32) * 512 + h * 64 + 32 * hh + 8 * s); }
        f32x16 O00, O01, O10, O11;
#pragma unroll
        for (int e = 0; e < 16; ++e) { O00[e] = 0.f; O01[e] = 0.f; O10[e] = 0.f; O11[e] = 0.f; }
        float mref0 = 0.f, mref1 = 0.f, lsum0 = 0.f, lsum1 = 0.f; bool fresh = true;
        u32x4 k0r = *(const u32x4*)(kg + (size_t)kc_lo * 64 * 512), k1r = *(const u32x4*)(kg + (size_t)kc_lo * 64 * 512 + 32 * 512), v0r = *(const u32x4*)(vg + kc_lo * 64), v1r = *(const u32x4*)(vg + kc_lo * 64 + 32 * 4096);
        for (int kc = kc_lo; kc <= kc_hi; ++kc) {
            LAS unsigned char* base = lds + ((kc - kc_lo) & 1) * AT_PAR;
            { LAS unsigned char* kw = base + ssel * AT_SEL; LAS unsigned char* vw = kw + AT_KBUF;
              *(LAS u32x4*)(kw + srow * AT_KROW + spc * 16) = k0r; *(LAS u32x4*)(kw + (srow + 32) * AT_KROW + spc * 16) = k1r;
              *(LAS u32x2*)(vw + srow * AT_VROW + spc * 16) = (u32x2){v0r.x, v0r.y}; *(LAS u32x2*)(vw + srow * AT_VROW + spc * 16 + 8) = (u32x2){v0r.z, v0r.w};
              *(LAS u32x2*)(vw + (srow + 32) * AT_VROW + spc * 16) = (u32x2){v1r.x, v1r.y}; *(LAS u32x2*)(vw + (srow + 32) * AT_VROW + spc * 16 + 8) = (u32x2){v1r.z, v1r.w}; }
            __syncthreads();
            if (kc < kc_hi) { const size_t ko = (size_t)(kc + 1) * 64 * 512; k0r = *(const u32x4*)(kg + ko); k1r = *(const u32x4*)(kg + ko + 32 * 512); v0r = *(const u32x4*)(vg + (kc + 1) * 64); v1r = *(const u32x4*)(vg + (kc + 1) * 64 + 32 * 4096); }
            const int delta = n - kc;
            if (delta >= 0 && delta <= 8) {
                const LAS unsigned char* kb_ = base + sel * AT_SEL; const LAS unsigned char* vb_ = kb_ + AT_KBUF;
#pragma unroll
                for (int kt = 0; kt < 2; ++kt) {
                    f32x16 S0, S1;
                    if (delta >= 3) { const float cf = bt[256], c0 = cf - mref0, c1 = cf - mref1;
#pragma unroll
                        for (int e = 0; e < 16; ++e) { S0[e] = c0; S1[e] = c1; }
                    } else { const LAS f32x4* t0p = (const LAS f32x4*)(lds + AT_TILES) + (2 * delta - kt + 1) * 256 + lane; const LAS f32x4* t1p = t0p + 256;
#pragma unroll
                        for (int q = 0; q < 4; ++q) { const f32x4 ta = t0p[q * 64], tb = t1p[q * 64];
#pragma unroll
                            for (int r = 0; r < 4; ++r) { S0[4 * q + r] = ta[r] - mref0; S1[4 * q + r] = tb[r] - mref1; } }
                    }
                    const LAS unsigned char* kp = kb_ + (32 * kt + c32) * AT_KROW + 64 * hh;
#pragma unroll
                    for (int s = 0; s < 4; ++s) { const bf16x8 kf = *(const LAS bf16x8*)(kp + 16 * s); S0 = MFMA32(kf, qf0[s], S0); S1 = MFMA32(kf, qf1[s], S1); }
                    float cm0 = max16(S0), cm1 = max16(S1);
                    cm0 = fmaxf(cm0, __shfl_xor(cm0, 32)); cm1 = fmaxf(cm1, __shfl_xor(cm1, 32));
                    if (fresh || __any(fmaxf(cm0, cm1) > 20.0f)) {
                        const float d0 = (fresh || cm0 > 20.0f) ? cm0 : 0.f, d1 = (fresh || cm1 > 20.0f) ? cm1 : 0.f;
                        const float s0 = fresh ? 1.0f : __builtin_amdgcn_exp2f(-d0), s1 = fresh ? 1.0f : __builtin_amdgcn_exp2f(-d1);
                        mref0 += d0; mref1 += d1; lsum0 *= s0; lsum1 *= s1;
#pragma unroll
                        for (int e = 0; e < 16; ++e) { S0[e] -= d0; S1[e] -= d1; O00[e] *= s0; O10[e] *= s0; O01[e] *= s1; O11[e] *= s1; }
                        fresh = false;
                    }
                    lsum0 += exp_sum16(S0); lsum1 += exp_sum16(S1);
                    const LAS unsigned char* vp = vb_ + c32 * AT_VROW + 8 * hh + 64 * kt;
#pragma unroll
                    for (int s2 = 0; s2 < 2; ++s2) {
                        const bf16x8 p0 = pack_half(S0, s2), p1 = pack_half(S1, s2);
                        const LAS unsigned char* v0p = vp + 32 * s2;
                        const s16x4 a0 = *(const LAS s16x4*)v0p, a1 = *(const LAS s16x4*)(v0p + 16), c0 = *(const LAS s16x4*)(v0p + 32 * AT_VROW), c1 = *(const LAS s16x4*)(v0p + 32 * AT_VROW + 16);
                        const bf16x8 vf0 = {a0[0], a0[1], a0[2], a0[3], a1[0], a1[1], a1[2], a1[3]}, vf1 = {c0[0], c0[1], c0[2], c0[3], c1[0], c1[1], c1[2], c1[3]};
                        O00 = MFMA32(vf0, p0, O00); O01 = MFMA32(vf0, p1, O01); O10 = MFMA32(vf1, p0, O10); O11 = MFMA32(vf1, p1, O11);
                    }
                }
            }
        }
        lsum0 += __shfl_xor(lsum0, 32); lsum1 += __shfl_xor(lsum1, 32);
        const float inv0 = 1.0f / lsum0, inv1 = 1.0f / lsum1;
        bf16_t* op0 = ATT + tok0 * 1024 + h * 64 + 4 * hh; bf16_t* op1 = op0 + 32 * 1024;
#pragma unroll
        for (int gq = 0; gq < 4; ++gq) { u32x2 w;
            w.x = pkbf(O00[4 * gq] * inv0, O00[4 * gq + 1] * inv0); w.y = pkbf(O00[4 * gq + 2] * inv0, O00[4 * gq + 3] * inv0); *(u32x2*)(op0 + 8 * gq) = w;
            w.x = pkbf(O10[4 * gq] * inv0, O10[4 * gq + 1] * inv0); w.y = pkbf(O10[4 * gq + 2] * inv0, O10[4 * gq + 3] * inv0); *(u32x2*)(op0 + 32 + 8 * gq) = w;
            w.x = pkbf(O01[4 * gq] * inv1, O01[4 * gq + 1] * inv1); w.y = pkbf(O01[4 * gq + 2] * inv1, O01[4 * gq + 3] * inv1); *(u32x2*)(op1 + 8 * gq) = w;
            w.x = pkbf(O11[4 * gq] * inv1, O11[4 * gq + 1] * inv1); w.y = pkbf(O11[4 * gq + 2] * inv1, O11[4 * gq + 3] * inv1); *(u32x2*)(op1 + 32 + 8 * gq) = w; }
        if (tid == 0) uq[0] = nxt_ticket;
        __syncthreads();
        cur = uq[0];
    }
    __syncthreads();
}
DI void carry_scan(const Args& a, unsigned char* ws, int blk, int G, int tid) {
    const float* SEND = (const float*)(ws + WS_SEND); bf16_t* UC = (bf16_t*)(ws + WS_UC);
    if (tid < 128)
    for (int idx = blk * 128 + tid; idx < 32768; idx += G * 128) {
        const int p = idx & 63, g = (idx >> 6) & 31, b = idx >> 11;
        const float* sp = SEND + ((size_t)(b * 64) * 32 + g) * 128 + p;
        float sr[64], si[64];
#pragma unroll
        for (int ch = 0; ch < 64; ++ch) { sr[ch] = sp[(size_t)ch * 4096]; si[ch] = sp[(size_t)ch * 4096 + 64]; }
        const double dt = exp((double)a.in[7][g]); const double zr = (double)a.in[5][g * 64 + p] * dt * 64.0, zi = (double)a.in[6][g * 64 + p] * dt * 64.0;
        double s, c; sincos(zi, &s, &c); const double e = exp(zr); const float lr = (float)(e * c), li = (float)(e * s);
        float cr = 0.f, ci = 0.f;
        bf16_t* up = UC + ((size_t)(g * 1024 + b * 64)) * 1152 + p;
#pragma unroll
        for (int ch = 0; ch < 64; ++ch) { const unsigned w = pkbf(cr, ci); up[(size_t)ch * 1152] = (bf16_t)(w & 0xffffu); up[(size_t)ch * 1152 + 64] = (bf16_t)(w >> 16);
            const float nr = lr * cr - li * ci + sr[ch], ni = lr * ci + li * cr + si[ch]; cr = nr; ci = ni; }
    }
}
DI void final_norm(const Args& a, unsigned char* ws, int blk, int G, int tid) {
    const int lane = tid & 63, wave = tid >> 6, gw = blk * 8 + wave, NGW = G * 8;
    const float* rss = (const float*)(ws + WS_ROWSS2); const bf16_t* H2B = (const bf16_t*)(ws + WS_H2B);
    const f32x4* gm = (const f32x4*)a.in[20] + 2 * lane;
    f32x4 gv[2][2];
#pragma unroll
    for (int j = 0; j < 2; ++j) { gv[j][0] = gm[128 * j]; gv[j][1] = gm[128 * j + 1]; }
    for (int m = gw; m < TOK; m += 4 * NGW) {
        u32x4 w[4][2]; float rs[4];
#pragma unroll
        for (int r = 0; r < 4; ++r) { const int mm = m + r * NGW; if (mm < TOK) { const u32x4* hp = (const u32x4*)(H2B + (size_t)mm * DM) + lane; w[r][0] = hp[0]; w[r][1] = hp[64]; rs[r] = rss[mm]; } }
#pragma unroll
        for (int r = 0; r < 4; ++r) { const int mm = m + r * NGW; if (mm < TOK) { const float sc = 1.0f / sqrtf(rs[r] * (1.0f / DM) + 1e-6f); f32x4* o = (f32x4*)(a.out + (size_t)mm * DM) + 2 * lane;
#pragma unroll
            for (int j = 0; j < 2; ++j) { const u32x4 ww = w[r][j];
                o[128 * j] = (f32x4){bf_lo(ww.x), bf_hi(ww.x), bf_lo(ww.y), bf_hi(ww.y)} * sc * gv[j][0]; o[128 * j + 1] = (f32x4){bf_lo(ww.z), bf_hi(ww.z), bf_lo(ww.w), bf_hi(ww.w)} * sc * gv[j][1]; } } } }
}
#define XB_TMO      128
#define XB_XCNT(j)  (256  + 64 * (j))
#define XB_XSUB(j)  (1280 + 64 * (j))
#define XB_XGEN(j)  (2304 + 64 * (j))
#define XB_TOP      3328
#define XB_TOPGEN   3392
#define XCD_BAR_WORDS 3456
#define XB_SPIN_CAP (1u << 18)

__device__ __forceinline__ unsigned xb_ld(unsigned* p)              { return __hip_atomic_load(p, __ATOMIC_RELAXED, __HIP_MEMORY_SCOPE_AGENT); }
__device__ __forceinline__ unsigned xb_add(unsigned* p, unsigned v) { return __hip_atomic_fetch_add(p, v, __ATOMIC_RELAXED, __HIP_MEMORY_SCOPE_AGENT); }
__device__ __forceinline__ unsigned xb_xcc_id() { return (unsigned)__builtin_amdgcn_s_getreg((3 << 11) | 20) & 0xFu; }
#define XB_SPIN(cond, bar) do { unsigned _sp = 0; while (cond) { __builtin_amdgcn_s_sleep(1); \
    if ((++_sp & 255u) == 0u) { if (xb_ld(&(bar)[XB_TMO])) break; if (_sp > XB_SPIN_CAP) { atomicAdd(&(bar)[XB_TMO], 1u); break; } } } } while (0)

struct XcdBarrier {
    unsigned* bar; unsigned x;
    volatile LAS unsigned* st;
};

__device__ __forceinline__ XcdBarrier xcd_barrier_post(unsigned* bar, volatile LAS unsigned* st) {
    XcdBarrier b; b.bar = bar; b.x = xb_xcc_id(); b.st = st;
    if (threadIdx.x == 0) (void)xb_add(&bar[XB_XCNT(b.x)], 1u);
    return b;
}
__device__ __forceinline__ void xcd_barrier_complete(unsigned* bar, unsigned x, unsigned& nloc, unsigned& nx) {
    const unsigned G = gridDim.x * gridDim.y * gridDim.z;
    unsigned sum, cnt, mine, sp = 0u;
    for (;;) {
        sum = 0u; cnt = 0u; mine = 0u;
#pragma unroll
        for (unsigned j = 0; j < 16; ++j) { const unsigned c = xb_ld(&bar[XB_XCNT(j)]); sum += c; cnt += (c > 0u) ? 1u : 0u; mine = (j == x) ? c : mine; }
        if (sum == G) break;
        __builtin_amdgcn_s_sleep(1);
        if ((++sp & 255u) == 0u) { if (xb_ld(&bar[XB_TMO])) break; if (sp > XB_SPIN_CAP) { atomicAdd(&bar[XB_TMO], 1u); break; } }
    }
    nloc = mine > 0u ? mine : 1u; nx = cnt > 0u ? cnt : 1u;
}

__device__ __forceinline__ void xcd_barrier(const XcdBarrier& b) {
    asm volatile("s_waitcnt vmcnt(0)" ::: "memory");
    __syncthreads();
    if (threadIdx.x == 0) {
        unsigned* bar = b.bar;
        __builtin_amdgcn_s_waitcnt(0);
        unsigned nloc = b.st[0], nx = b.st[1];
        if (nloc == 0u) { xcd_barrier_complete(bar, b.x, nloc, nx); b.st[0] = nloc; b.st[1] = nx; }
        const unsigned old = xb_add(&bar[XB_XSUB(b.x)], 1u);
        const unsigned gen = old / nloc;
        if (old + 1u == (gen + 1u) * nloc) {
            __builtin_amdgcn_fence(__ATOMIC_RELEASE, "agent");
            asm volatile("s_waitcnt vmcnt(0)" ::: "memory");
            const unsigned og = xb_add(&bar[XB_TOP], 1u);
            const unsigned tg = og / nx;
            if (og + 1u == (tg + 1u) * nx) xb_add(&bar[XB_TOPGEN], 1u);
            else XB_SPIN(xb_ld(&bar[XB_TOPGEN]) == tg, bar);
            __builtin_amdgcn_fence(__ATOMIC_ACQUIRE, "agent");
            xb_add(&bar[XB_XGEN(b.x)], 1u);
            asm volatile("s_waitcnt vmcnt(0)" ::: "memory");
        } else {
            XB_SPIN(xb_ld(&bar[XB_XGEN(b.x)]) == gen, bar);
            __builtin_amdgcn_fence(__ATOMIC_ACQUIRE, "agent");
            asm volatile("s_waitcnt vmcnt(0)" ::: "memory");
        }
    }
    __syncthreads();
}

constexpr int N_PHASES = 11;
constexpr int LDS_BARST = 131072 + 64;
template <bool COOP> __global__ void __launch_bounds__(512, 2) fwd(Args a) {
    extern __shared__ __attribute__((aligned(16))) unsigned char lds_raw[];
    LAS unsigned char* lds = (LAS unsigned char*)lds_raw;
    const int tid = threadIdx.x, blk = blockIdx.x, G = gridDim.x; unsigned char* ws = a.ws;
    const int lo = a.ph_lo, hi = a.ph_hi;
#ifndef PROBE_PHASE
#define PROBE_PHASE -1
#endif
#define IN(k) (lo <= (k) && (k) < hi)
#define REP(k) for (int rep_ = 0; rep_ < ((k) == PROBE_PHASE ? 2 : 1); ++rep_)
#define SEAM(k) do { if constexpr (COOP) { if (IN(k) && IN((k) + 1)) xcd_barrier(bar); } } while (0)
    bf16_t *WIN = (bf16_t*)(ws + WS_WIN), *WGLU = (bf16_t*)(ws + WS_WGLU), *WAB = (bf16_t*)(ws + WS_WAB), *WOUT = (bf16_t*)(ws + WS_WOUT), *WFF1 = (bf16_t*)(ws + WS_WFF1), *WFF2 = (bf16_t*)(ws + WS_WFF2);
    bf16_t *MCAT = (bf16_t*)(ws + WS_MCAT), *WEND = (bf16_t*)(ws + WS_WEND), *UC = (bf16_t*)(ws + WS_UC), *XN = (bf16_t*)(ws + WS_XN), *AG = XN, *MIXED = (bf16_t*)(ws + WS_MIXED), *Qb = (bf16_t*)(ws + WS_Q), *Kb = (bf16_t*)(ws + WS_K), *YS = Kb;
    bf16_t *VT = (bf16_t*)(ws + WS_VT), *GATES = (bf16_t*)(ws + WS_GATES), *HB = (bf16_t*)(ws + WS_HB), *HID = (bf16_t*)(ws + WS_HID);
    float *SEND = (float*)(ws + WS_SEND), *RSS1 = (float*)(ws + WS_ROWSS1), *RSS2 = (float*)(ws + WS_ROWSS2);
    using namespace pg8;
    XcdBarrier bar; bar.bar = (unsigned*)(ws + WS_BAR); bar.x = 0; bar.st = (volatile LAS unsigned*)(lds + LDS_BARST);
    if constexpr (COOP) {
        if (tid == 0) { bar.st[0] = 0u; bar.st[1] = 0u; }
        __syncthreads();
        bar = xcd_barrier_post((unsigned*)(ws + WS_BAR), (volatile LAS unsigned*)(lds + LDS_BARST));
        if (hi > N_PHASES) cg::this_grid().sync();
    }
    if (IN(0)) REP(0) { prologue(lds, a, ws, blk, G, tid); }
    SEAM(0);
    if (IN(1)) REP(1) { Gemm g{XN, WIN, 1024, 1024, 1024, 256}; StaticOrder S; S.init(TOK, 4096, G, blk); EpiIn E{Qb, Kb, VT, UC, GATES, a.in[3]};
        gemm_phase<EpiIn, StaticOrder, true, true>(lds, g, S, E); }
    SEAM(1);
    if (IN(2)) REP(2) { { Gemm g{UC + 128, WEND, 1024, 1152, 1024, 128}; EndOrder S{G, blk}; EpiSend E{SEND}; gemm_phase<EpiSend, EndOrder, true, true>(lds, g, S, E); }
        attn_phase(lds, Qb, AG, Kb, VT, a.in[4], (unsigned*)(ws + WS_PCNT), tid);
#if PROBE_PHASE == 22
        if constexpr (COOP) { xcd_barrier(bar); if (blk == 0 && tid == 0) __hip_atomic_store((unsigned*)(ws + WS_PCNT), 0u, __ATOMIC_RELAXED, __HIP_MEMORY_SCOPE_AGENT); xcd_barrier(bar);
            attn_phase(lds, Qb, AG, Kb, VT, a.in[4], (unsigned*)(ws + WS_PCNT), tid); }
#endif
        }
    SEAM(2);
    if (IN(3)) REP(3) { carry_scan(a, ws, blk, G, tid); }
    SEAM(3);
    if (IN(4)) REP(4) { Gemm g{UC, MCAT, 1152, 1152, 1152, 256}; OutOrder S{G, blk}; EpiSsmOut E{YS}; gemm_phase<EpiSsmOut, OutOrder, true, true>(lds, g, S, E); }
    SEAM(4);
    if (IN(5)) REP(5) { Gemm g{YS, WGLU, 512, 512, 512, 256}; StaticOrder S; S.init(TOK, 1024, G, blk); EpiGlu E{AG}; gemm_phase<EpiGlu, StaticOrder, true, true>(lds, g, S, E); }
    SEAM(5);
    if (IN(6)) REP(6) { Gemm g{AG, WAB, 1024, 1024, 1024, 256}; MixOrder S; S.B.init(TOK, 1024, G, blk); EpiMix E{GATES, MIXED}; gemm_phase<EpiMix, MixOrder, true, true>(lds, g, S, E); }
    SEAM(6);
    if (IN(7)) REP(7) { Gemm g{MIXED, WOUT, 1024, 1024, 1024, 256}; StaticOrder S; S.init(TOK, 1024, G, blk); EpiResid<false> E{a.in[0], nullptr, HB, RSS1};
        gemm_phase<EpiResid<false>, StaticOrder, true, true>(lds, g, S, E); }
    SEAM(7);
    if (IN(8)) REP(8) { Gemm g{HB, WFF1, 1024, 1024, 1024, 256}; StaticOrder S; S.init(TOK, 4096, G, blk); EpiFF1 E{RSS1, HID}; gemm_phase<EpiFF1, StaticOrder, true, true>(lds, g, S, E); }
    SEAM(8);
    if (IN(9)) REP(9) { Gemm g{HID, WFF2, 4096, 4096, 4096, 256}; StaticOrder S; S.init(TOK, 1024, G, blk); EpiResid<true> E{nullptr, HB, (bf16_t*)(ws + WS_H2B), RSS2};
        gemm_phase<EpiResid<true>, StaticOrder, true, true>(lds, g, S, E); }
    SEAM(9);
    if (IN(10)) REP(10) { final_norm(a, ws, blk, G, tid); }
#undef IN
#undef SEAM
}
extern "C" void kernel_launch(void* const* d_in, const int* in_sizes, int n_in, void* d_out, int out_size, void* d_ws, size_t ws_size, hipStream_t stream) {
    static int grid = 0;
    if (grid == 0) {
        if (n_in != 21 || in_sizes[0] != TOK * DM || out_size != TOK * DM || ws_size < WS_END) { fprintf(stderr, "kernel_launch: unexpected shapes (n_in %d, in0 %d, out %d, ws %zu)\n", n_in, n_in > 0 ? in_sizes[0] : -1, out_size, ws_size); grid = -1; return; }
        int dev = 0, cus = 0, per_cu = 0;
        hipGetDevice(&dev); hipDeviceGetAttribute(&cus, hipDeviceAttributeMultiprocessorCount, dev);
        hipFuncSetAttribute((const void*)fwd<true>, hipFuncAttributeMaxDynamicSharedMemorySize, LDS_BYTES);
        hipFuncSetAttribute((const void*)fwd<false>, hipFuncAttributeMaxDynamicSharedMemorySize, LDS_BYTES);
        hipOccupancyMaxActiveBlocksPerMultiprocessor(&per_cu, (const void*)fwd<true>, 512, LDS_BYTES);
        (void)hipGetLastError();
        if (per_cu < 1) { fprintf(stderr, "kernel_launch: occupancy query says %d workgroups per CU\n", per_cu); per_cu = 1; }
        grid = cus;
        if (grid > 256) grid = 256;
    }
    if (grid < 0) return;
    Args a{};
    for (int i = 0; i < 21; ++i) a.in[i] = (const float*)d_in[i];
    a.out = (float*)d_out; a.ws = (unsigned char*)d_ws;
    if (hipMemsetAsync((char*)d_ws + WS_BAR, 0, BAR_BYTES, stream) != hipSuccess) { fprintf(stderr, "kernel_launch: memset of the barrier words failed\n"); return; }
#if ONE_LAUNCH
    a.ph_lo = 0; a.ph_hi = N_PHASES;
    void* args[] = {&a};
    hipError_t e = hipLaunchCooperativeKernel((const void*)fwd<true>, dim3(grid), dim3(512), args, LDS_BYTES, stream);
    if (e != hipSuccess) fprintf(stderr, "cooperative launch failed: %s (grid %d)\n", hipGetErrorString(e), grid);
#else
    for (int li = 0; li < N_PHASES; ++li) { a.ph_lo = li; a.ph_hi = li + 1; hipLaunchKernelGGL(fwd<false>, dim3(grid), dim3(512), LDS_BYTES, stream, a); }
#endif
}
```

```cpp
#include <hip/hip_runtime.h>
#include <hip/hip_cooperative_groups.h>
#include <cstdio>
#include <cstdint>
namespace cg = cooperative_groups;
#ifndef ONE_LAUNCH
#define ONE_LAUNCH 1
#endif
#define DI __device__ __forceinline__
typedef float f32x2 __attribute__((ext_vector_type(2)));
typedef float f32x16 __attribute__((ext_vector_type(16)));
typedef unsigned u32x2 __attribute__((ext_vector_type(2)));
typedef short s16x4 __attribute__((ext_vector_type(4)));
typedef __bf16 bf2_t __attribute__((ext_vector_type(2)));
DI unsigned pkbf(float lo, float hi) { f32x2 v = {lo, hi}; return __builtin_bit_cast(unsigned, __builtin_convertvector(v, bf2_t)); }
DI float bf_lo(unsigned w) { return __uint_as_float(w << 16); }
DI float bf_hi(unsigned w) { return __uint_as_float(w & 0xffff0000u); }
DI float sigmoid_f(float x) { return __builtin_amdgcn_rcpf(1.0f + __expf(-x)); }
DI unsigned pk4u8(float a, float b, float c, float d) { return (unsigned)(a * 255.0f + 0.5f) | ((unsigned)(b * 255.0f + 0.5f) << 8) | ((unsigned)(c * 255.0f + 0.5f) << 16) | ((unsigned)(d * 255.0f + 0.5f) << 24); }
DI float u8f(unsigned w, int e) { return (float)((w >> (8 * e)) & 0xffu); }
namespace pg8 {
#define PG8_LAS __attribute__((address_space(3)))
typedef unsigned short bf16_t;
typedef short bf16x8 __attribute__((ext_vector_type(8)));
typedef float f32x4 __attribute__((ext_vector_type(4)));
typedef unsigned u32x4 __attribute__((ext_vector_type(4)));
constexpr int BM = 256, BK = 64, HALF = 128, HTB = HALF * BK * 2  , STAGE_BYTES = 8 * HTB, NXCD = 8, WGM = 8;

__host__ __device__ __forceinline__ int lds_byte(int r, int c) { const int st = (r >> 4) * 2 + (c >> 5), rr = r & 15, cc = c & 31, ob = rr * 64 + cc * 2; return st * 1024 + (ob ^ (((ob >> 9) & 1) << 5)); }
__host__ __device__ __forceinline__ void stage_rc(int b, int& R, int& C) { const int st = b / 1024, sb = b % 1024, swz = sb ^ (((sb >> 9) & 1) << 5); R = (st >> 1) * 16 + swz / 64; C = (st & 1) * 32 + (swz % 64) / 2; }
__host__ __device__ __forceinline__ int perm32(int rho) { const int n = rho >> 4, i = rho & 15; return 8 * (i >> 2) + 4 * n + (i & 3); }

struct Unit { int pm, pn, seg; };
struct Gemm { const bf16_t* A; const bf16_t* Bt; int K, lda, ldb, btile; };

struct StaticOrder {
    int nM, nN, nwg, G, c, wgm;
    __host__ __device__ void init(int M, int N, int G_, int c_, int wgm_ = WGM) { nM = M / BM; nN = N / BM; nwg = nM * nN; G = G_; c = c_; wgm = wgm_; }
    __host__ __device__ bool next(int i, Unit& u) const {
        const long L = (long)i * G + c; if (L >= nwg) return false;
        int wgid = (int)L; { const int q = nwg / NXCD, r = nwg % NXCD, xcd = wgid % NXCD, off = wgid / NXCD; wgid = (xcd < r ? xcd * (q + 1) : r * (q + 1) + (xcd - r) * q) + off; }
        const int nig = wgm * nN, gid = wgid / nig, fm = gid * wgm, gsz = (nM - fm) < wgm ? (nM - fm) : wgm;
        u.pm = fm + ((wgid % nig) % gsz); u.pn = (wgid % nig) / gsz; return true;
    }
    __device__ __forceinline__ int kt(const Unit&, int ntf) const { return ntf; }
    __device__ __forceinline__ size_t koff(const Unit&) const { return 0; }
    __device__ __forceinline__ void a_ready(const Unit&) const {}
    __device__ __forceinline__ void done(const Unit&) const {}
};

template <class Epi, class Sched, bool ALIGN_EPI = false, bool SP2 = false>
__device__ __forceinline__ void gemm_phase(PG8_LAS unsigned char* lds, const Gemm g, const Sched& S, const Epi& E) {
    const int tid = threadIdx.x, wid = __builtin_amdgcn_readfirstlane(tid >> 6), lane = tid & 63, wr = wid >> 2, wc = wid & 3, fr = lane & 15, fq = lane >> 4;
    const int ntf = g.K / BK;
    unsigned voffA[2], voffB[2];
#pragma unroll
    for (int i = 0; i < 2; ++i) { int R, C; stage_rc(tid * 16 + i * 8192, R, C); const int Rb = Epi::PERM ? ((R & ~31) + perm32(R & 31)) : R;
        voffA[i] = (unsigned)(R * g.lda + C) * 2u; voffB[i] = (unsigned)(Rb * g.ldb + C) * 2u; }
    const size_t kstep = (size_t)(BK * 2);
    const size_t hstepA = (size_t)HALF * g.lda * 2, hstepB = (size_t)HALF * g.ldb * 2;
    const size_t tstepA = 2 * hstepA, tstepB = (size_t)g.btile * g.ldb * 2;
    const unsigned ldsw = (unsigned)wid * 1024u;
    const int aoff = lds_byte(wr * 64 + fr, fq * 8), boff = lds_byte(wc * 32 + fr, fq * 8);
#define PG8_SA(b, h) (((b) * 2 + (h)) * HTB)
#define PG8_SB(b, h) ((4 + (b) * 2 + (h)) * HTB)
#define PG8_STAGE(bufoff, gbase, voff) do { _Pragma("unroll") for (int _i = 0; _i < 2; ++_i) \
        __builtin_amdgcn_global_load_lds((const unsigned*)((const char*)(gbase) + (voff)[_i]), (PG8_LAS unsigned*)(lds + (bufoff) + ldsw + _i * 8192), 16, 0, 0); } while (0)
#define PG8_LDA(dst, b, h) do { _Pragma("unroll") for (int m = 0; m < 4; ++m) _Pragma("unroll") for (int k = 0; k < 2; ++k) dst[m][k] = *(const PG8_LAS bf16x8*)(lds + PG8_SA(b, h) + aoff + m * 2048 + k * 1024); } while (0)
#define PG8_LDB(dst, b, h) do { _Pragma("unroll") for (int n = 0; n < 2; ++n) _Pragma("unroll") for (int k = 0; k < 2; ++k) dst[n][k] = *(const PG8_LAS bf16x8*)(lds + PG8_SB(b, h) + boff + n * 2048 + k * 1024); } while (0)
#define PG8_MMA(ai, bj, At, Bt) do { __builtin_amdgcn_s_setprio(1); _Pragma("unroll") for (int m = 0; m < 4; ++m) _Pragma("unroll") for (int n = 0; n < 2; ++n) _Pragma("unroll") for (int k = 0; k < 2; ++k) \
        acc[ai][bj][m][n] = __builtin_amdgcn_mfma_f32_16x16x32_bf16(Bt[n][k], At[m][k], acc[ai][bj][m][n], 0, 0, 0); __builtin_amdgcn_s_setprio(0); } while (0)
#define PG8_WAIT_V(n) asm volatile("s_waitcnt vmcnt(" #n ")" ::: "memory")
#define PG8_WAIT_L(n) asm volatile("s_waitcnt lgkmcnt(" #n ")" ::: "memory")
#define PG8_BAR __builtin_amdgcn_s_barrier()
#define PG8_SCHED __builtin_amdgcn_sched_barrier(0)
    Unit cur, nxt; int ui = 0;
    if (!S.next(0, cur)) return;
    f32x4 acc[2][2][4][2];
#pragma unroll
    for (int a = 0; a < 2; ++a)
#pragma unroll
        for (int b = 0; b < 2; ++b)
#pragma unroll
            for (int m = 0; m < 4; ++m)
#pragma unroll
                for (int n = 0; n < 2; ++n) acc[a][b][m][n] = (f32x4){0.f, 0.f, 0.f, 0.f};
    bf16x8 At[4][2], B0[2][2], B1[2][2];
    const char* cA = (const char*)g.A + (size_t)cur.pm * tstepA + S.koff(cur); const char* cB = (const char*)g.Bt + (size_t)cur.pn * tstepB + S.koff(cur);
    S.a_ready(cur);
    if constexpr (SP2) {
        PG8_STAGE(PG8_SB(0, 0), cB, voffB); PG8_STAGE(PG8_SB(0, 1), cB + hstepB, voffB); PG8_STAGE(PG8_SA(0, 0), cA, voffA); PG8_STAGE(PG8_SA(0, 1), cA + hstepA, voffA);
        if (wr == 1) PG8_BAR;
        PG8_WAIT_V(2); PG8_BAR;
        PG8_STAGE(PG8_SB(1, 0), cB + kstep, voffB); PG8_STAGE(PG8_SA(1, 0), cA + kstep, voffA); PG8_STAGE(PG8_SB(1, 1), cB + hstepB + kstep, voffB);
        PG8_WAIT_V(6); PG8_BAR;
    } else {
        PG8_STAGE(PG8_SB(0, 0), cB, voffB); PG8_STAGE(PG8_SA(0, 0), cA, voffA); PG8_STAGE(PG8_SB(0, 1), cB + hstepB, voffB); PG8_STAGE(PG8_SA(0, 1), cA + hstepA, voffA);
        if (wr == 1) PG8_BAR;
        PG8_WAIT_V(4); PG8_BAR;
        PG8_STAGE(PG8_SB(1, 0), cB + kstep, voffB); PG8_STAGE(PG8_SA(1, 0), cA + kstep, voffA); PG8_STAGE(PG8_SB(1, 1), cB + hstepB + kstep, voffB);
        PG8_WAIT_V(6); PG8_BAR;
    }
    for (;;) {
        const bool has_next = S.next(ui + 1, nxt);
        const char* nA = has_next ? (const char*)g.A + (size_t)nxt.pm * tstepA + S.koff(nxt) : cA; const char* nB = has_next ? (const char*)g.Bt + (size_t)nxt.pn * tstepB + S.koff(nxt) : cB;
        const int nt = S.kt(cur, ntf);
        for (int t = 0; t < nt; t += 2) {
            const bool last = (t == nt - 2);
            const char* a1 = cA + (size_t)(t + 1) * kstep;
            const char* a2 = last ? nA : cA + (size_t)(t + 2) * kstep; const char* b2 = last ? nB : cB + (size_t)(t + 2) * kstep;
            const char* a3 = a2 + kstep; const char* b3 = b2 + kstep;
            if (last && has_next) S.a_ready(nxt);
            if constexpr (SP2) {
            PG8_LDB(B0, 0, 0); PG8_LDB(B1, 0, 1); PG8_SCHED; PG8_LDA(At, 0, 0); PG8_STAGE(PG8_SA(1, 1), a1 + hstepA, voffA);
            PG8_WAIT_V(8); PG8_WAIT_L(0); PG8_BAR; PG8_MMA(0, 0, At, B0); PG8_MMA(0, 1, At, B1); PG8_BAR; PG8_SCHED;
            PG8_LDA(At, 0, 1); PG8_STAGE(PG8_SB(0, 0), b2, voffB); PG8_STAGE(PG8_SB(0, 1), b2 + hstepB, voffB); PG8_STAGE(PG8_SA(0, 0), a2, voffA);
            PG8_WAIT_V(8); PG8_WAIT_L(0); PG8_BAR; PG8_MMA(1, 0, At, B0); PG8_MMA(1, 1, At, B1); PG8_BAR; PG8_SCHED;
            PG8_LDB(B0, 1, 0); PG8_LDB(B1, 1, 1); PG8_SCHED; PG8_LDA(At, 1, 0); PG8_STAGE(PG8_SA(0, 1), a2 + hstepA, voffA);
            PG8_WAIT_V(8); PG8_WAIT_L(0); PG8_BAR; PG8_MMA(0, 0, At, B0); PG8_MMA(0, 1, At, B1); PG8_BAR; PG8_SCHED;
            PG8_LDA(At, 1, 1); PG8_STAGE(PG8_SB(1, 0), b3, voffB); PG8_STAGE(PG8_SB(1, 1), b3 + hstepB, voffB); PG8_STAGE(PG8_SA(1, 0), a3, voffA);
            PG8_WAIT_V(8); PG8_WAIT_L(0); PG8_BAR; PG8_MMA(1, 0, At, B0); PG8_MMA(1, 1, At, B1); PG8_BAR; PG8_SCHED;
            } else {
            PG8_LDB(B0, 0, 0); PG8_SCHED; PG8_LDA(At, 0, 0); PG8_STAGE(PG8_SA(1, 1), a1 + hstepA, voffA);
            PG8_WAIT_L(8); PG8_BAR; PG8_WAIT_L(0); PG8_MMA(0, 0, At, B0); PG8_BAR; PG8_SCHED;
            PG8_LDB(B1, 0, 1); PG8_STAGE(PG8_SB(0, 0), b2, voffB);
            PG8_BAR; PG8_WAIT_L(0); PG8_MMA(0, 1, At, B1); PG8_BAR;
            PG8_LDA(At, 0, 1); PG8_STAGE(PG8_SA(0, 0), a2, voffA);
            PG8_BAR; PG8_WAIT_L(0); PG8_MMA(1, 0, At, B0); PG8_BAR; PG8_SCHED;
            PG8_STAGE(PG8_SB(0, 1), b2 + hstepB, voffB);
            PG8_WAIT_V(6); PG8_BAR; PG8_MMA(1, 1, At, B1); PG8_BAR;
            PG8_LDB(B0, 1, 0); PG8_SCHED; PG8_LDA(At, 1, 0); PG8_STAGE(PG8_SA(0, 1), a2 + hstepA, voffA);
            PG8_WAIT_L(8); PG8_BAR; PG8_WAIT_L(0); PG8_MMA(0, 0, At, B0); PG8_BAR; PG8_SCHED;
            PG8_LDB(B1, 1, 1); PG8_STAGE(PG8_SB(1, 0), b3, voffB);
            PG8_BAR; PG8_WAIT_L(0); PG8_MMA(0, 1, At, B1); PG8_BAR;
            PG8_LDA(At, 1, 1); PG8_STAGE(PG8_SA(1, 0), a3, voffA);
            PG8_BAR; PG8_WAIT_L(0); PG8_MMA(1, 0, At, B0); PG8_BAR; PG8_SCHED;
            PG8_STAGE(PG8_SB(1, 1), b3 + hstepB, voffB);
            PG8_WAIT_V(6); PG8_BAR; PG8_MMA(1, 1, At, B1); PG8_BAR;
            }
        }
        if constexpr (ALIGN_EPI) { if (wr == 0) PG8_BAR; }
        bool part_ = false; if constexpr (Epi::HAS_MID) part_ = S.partial(cur);
        if constexpr (!Epi::AFTER_DRAIN) { if constexpr (Epi::HAS_MID) { if (part_) E.mid(acc, cur, wr, wc, fr, fq); else E(acc, cur, wr, wc, fr, fq); } else E(acc, cur, wr, wc, fr, fq); S.done(cur); }
        if (!has_next) break;
        if (!part_)
#pragma unroll
        for (int a = 0; a < 2; ++a)
#pragma unroll
            for (int b = 0; b < 2; ++b)
#pragma unroll
                for (int m = 0; m < 4; ++m)
#pragma unroll
                    for (int n = 0; n < 2; ++n) acc[a][b][m][n] = (f32x4){0.f, 0.f, 0.f, 0.f};
        cur = nxt; cA = nA; cB = nB; ++ui;
        if constexpr (ALIGN_EPI) { if (wr == 1) PG8_BAR; }
    }
    PG8_WAIT_V(0);
    if constexpr (!ALIGN_EPI) { if (wr == 0) PG8_BAR; }
    PG8_BAR;
    if constexpr (Epi::AFTER_DRAIN) { E.fused(acc, cur, wr, wc, fr, fq, lds, wid, lane); S.done(cur); }
#undef PG8_SA
#undef PG8_SB
#undef PG8_STAGE
#undef PG8_LDA
#undef PG8_LDB
#undef PG8_MMA
#undef PG8_WAIT_V
#undef PG8_WAIT_L
#undef PG8_BAR
#undef PG8_SCHED
}
}
namespace pg8 {
DI u32x4 pack8(f32x4 v0, f32x4 v1) { u32x4 w; w.x = pkbf(v0[0], v0[1]); w.y = pkbf(v0[2], v0[3]); w.z = pkbf(v1[0], v1[1]); w.w = pkbf(v1[2], v1[3]); return w; }
DI f32x4 sig4(f32x4 v) { f32x4 o; o[0] = sigmoid_f(v[0]); o[1] = sigmoid_f(v[1]); o[2] = sigmoid_f(v[2]); o[3] = sigmoid_f(v[3]); return o; }
DI float gelu_tanh(float x) { const float t = 1.5957691216f * (x + 0.044715f * x * x * x); return x * sigmoid_f(t); }
DI f32x4 gelu4(f32x4 v) { f32x4 o; o[0] = gelu_tanh(v[0]); o[1] = gelu_tanh(v[1]); o[2] = gelu_tanh(v[2]); o[3] = gelu_tanh(v[3]); return o; }
#define EPI_ROWS for (int ai = 0; ai < 2; ++ai) _Pragma("unroll") for (int m = 0; m < 4; ++m)

struct EpiIn {
    static constexpr bool PERM = true, AFTER_DRAIN = false, HAS_MID = false;
    bf16_t *Q, *Kb, *VT, *UC, *GATES; const float* b_gate;
    DI void operator()(const f32x4 (&acc)[2][2][4][2], const Unit& u, int wr, int wc, int fr, int fq) const {
        const int pn = u.pn, rbase = u.pm * BM + wr * 64 + fr, cb = wc * 32 + 8 * fq;
        if (pn < 4) {
            bf16_t* dst = pn < 2 ? Q : Kb; const float sc = pn < 2 ? 0.125f * 1.4426950408889634f : 1.0f;   const int c0 = (pn & 1) * 256 + cb;
#pragma unroll
            EPI_ROWS { const int row = rbase + ai * HALF + m * 16;
#pragma unroll
                for (int bj = 0; bj < 2; ++bj) *(u32x4*)(dst + (size_t)row * 512 + c0 + bj * HALF) = pack8(acc[ai][bj][m][0] * sc, acc[ai][bj][m][1] * sc); }
        } else if (pn < 6) {
#pragma unroll
            EPI_ROWS { const int row = rbase + ai * HALF + m * 16, b = row >> 12, s = row & 4095;
#pragma unroll
                for (int bj = 0; bj < 2; ++bj) { const int cv = (pn - 4) * 256 + bj * HALF + cb, h = cv >> 6, d = cv & 63;
                    bf16_t* p = VT + ((size_t)((b * 8 + h) * 64 + d)) * 4096 + s; const u32x4 w = pack8(acc[ai][bj][m][0] * 1.0f, acc[ai][bj][m][1] * 1.0f);
                    p[0] = (bf16_t)(w.x & 0xffffu); p[4096] = (bf16_t)(w.x >> 16); p[2 * 4096] = (bf16_t)(w.y & 0xffffu); p[3 * 4096] = (bf16_t)(w.y >> 16);
                    p[4 * 4096] = (bf16_t)(w.z & 0xffffu); p[5 * 4096] = (bf16_t)(w.z >> 16); p[6 * 4096] = (bf16_t)(w.w & 0xffffu); p[7 * 4096] = (bf16_t)(w.w >> 16); } }
        } else if (pn < 8) {
#pragma unroll
            EPI_ROWS { const int row = rbase + ai * HALF + m * 16, bc = row >> 6, j = row & 63;
#pragma unroll
                for (int bj = 0; bj < 2; ++bj) { const int cu = (pn - 6) * 256 + bj * HALF + cb, g = cu >> 4, hh = cu & 15;
                    *(u32x4*)(UC + ((size_t)(g * 1024 + bc)) * 1152 + 128 + j * 16 + hh) = pack8(acc[ai][bj][m][0] * 1.0f, acc[ai][bj][m][1] * 1.0f); } }
        } else {
#pragma unroll
            for (int bj = 0; bj < 2; ++bj) { const int cgt = (pn - 8) * 256 + bj * HALF + cb; const f32x4 b0 = *(const f32x4*)(b_gate + cgt), b1 = *(const f32x4*)(b_gate + cgt + 4);
#pragma unroll
                EPI_ROWS { const int row = rbase + ai * HALF + m * 16;
                    const f32x4 s0 = sig4(acc[ai][bj][m][0] + b0), s1 = sig4(acc[ai][bj][m][1] + b1);
                    *(u32x2*)((unsigned char*)GATES + (size_t)row * 2048 + cgt) = (u32x2){pk4u8(s0[0], s0[1], s0[2], s0[3]), pk4u8(s1[0], s1[1], s1[2], s1[3])}; } }
        }
    }
};
struct EpiSend {
    static constexpr bool PERM = true, AFTER_DRAIN = false, HAS_MID = false;
    float* SEND;
    DI void operator()(const f32x4 (&acc)[2][2][4][2], const Unit& u, int wr, int wc, int fr, int fq) const {
        const int g = u.pm >> 2, rbase = (u.pm & 3) * BM + wr * 64 + fr, c = wc * 32 + 8 * fq;
#pragma unroll
        EPI_ROWS { const int bc = rbase + ai * HALF + m * 16; float* p = SEND + ((size_t)bc * 32 + g) * 128 + c; *(f32x4*)p = acc[ai][0][m][0]; *(f32x4*)(p + 4) = acc[ai][0][m][1]; }
    }
};
struct EpiSsmOut {
    static constexpr bool PERM = true, AFTER_DRAIN = false, HAS_MID = false;
    bf16_t* YS;
    DI void operator()(const f32x4 (&acc)[2][2][4][2], const Unit& u, int wr, int wc, int fr, int fq) const {
        const int g = u.pm >> 2, rbase = (u.pm & 3) * BM + wr * 64 + fr, cb = (u.pn & 3) * BM + wc * 32 + 8 * fq;
#pragma unroll
        EPI_ROWS { const int bc = rbase + ai * HALF + m * 16;
#pragma unroll
            for (int bj = 0; bj < 2; ++bj) { const int n = cb + bj * HALF, i = n >> 4, h0 = n & 15;
                *(u32x4*)(YS + ((size_t)bc * 64 + i) * 512 + g * 16 + h0) = pack8(gelu4(acc[ai][bj][m][0]), gelu4(acc[ai][bj][m][1])); } }
    }
};
struct EpiGlu {
    static constexpr bool PERM = true, AFTER_DRAIN = false, HAS_MID = false;
    bf16_t* GLU;
    DI void operator()(const f32x4 (&acc)[2][2][4][2], const Unit& u, int wr, int wc, int fr, int fq) const {
        const int rbase = u.pm * BM + wr * 64 + fr, col = u.pn * HALF + wc * 32 + 8 * fq;
#pragma unroll
        EPI_ROWS { const int row = rbase + ai * HALF + m * 16;
            *(u32x4*)(GLU + (size_t)row * 1024 + 512 + col) = pack8(acc[ai][0][m][0] * sig4(acc[ai][1][m][0]), acc[ai][0][m][1] * sig4(acc[ai][1][m][1])); }
    }
};
struct EpiMix {
    static constexpr bool PERM = true, AFTER_DRAIN = false, HAS_MID = true;
    const bf16_t* GATES; bf16_t* MIXED;
    DI void mid(f32x4 (&acc)[2][2][4][2], const Unit& u, int wr, int wc, int fr, int fq) const {
        const unsigned char* gp = (const unsigned char*)GATES + (size_t)(u.pm * BM + wr * 64 + fr) * 2048 + u.pn * BM + wc * 32 + 8 * fq;
#pragma unroll
        EPI_ROWS {
#pragma unroll
            for (int bj = 0; bj < 2; ++bj) { const unsigned char* q = gp + (size_t)(ai * HALF + m * 16) * 2048 + bj * HALF; const u32x2 ga = *(const u32x2*)q, gb = *(const u32x2*)(q + 1024);
                f32x4 r0, r1;
#pragma unroll
                for (int e = 0; e < 4; ++e) { r0[e] = u8f(ga.x, e) * __builtin_amdgcn_rcpf(fmaxf(u8f(gb.x, e), 1e-18f)); r1[e] = u8f(ga.y, e) * __builtin_amdgcn_rcpf(fmaxf(u8f(gb.y, e), 1e-18f)); }
                acc[ai][bj][m][0] *= r0; acc[ai][bj][m][1] *= r1; }
            asm volatile("" ::: "memory"); }
    }
    DI void operator()(const f32x4 (&acc)[2][2][4][2], const Unit& u, int wr, int wc, int fr, int fq) const {
        const int rbase = u.pm * BM + wr * 64 + fr, cb = u.pn * BM + wc * 32 + 8 * fq;
#pragma unroll
        EPI_ROWS { const int row = rbase + ai * HALF + m * 16;
#pragma unroll
            for (int bj = 0; bj < 2; ++bj) { const int c = cb + bj * HALF; const u32x2 gb = *(const u32x2*)((const unsigned char*)GATES + (size_t)row * 2048 + 1024 + c);
                f32x4 b0, b1;
#pragma unroll
                for (int e = 0; e < 4; ++e) { b0[e] = fmaxf(u8f(gb.x, e), 1e-18f) * (1.0f / 255.0f); b1[e] = fmaxf(u8f(gb.y, e), 1e-18f) * (1.0f / 255.0f); }
                *(u32x4*)(MIXED + (size_t)row * 1024 + c) = pack8(acc[ai][bj][m][0] * b0, acc[ai][bj][m][1] * b1); } }
    }
};
template <bool BASE_BF16> struct EpiResid {
    static constexpr bool PERM = true, AFTER_DRAIN = false, HAS_MID = false;
    const float* basef; const bf16_t* baseb; bf16_t* HB; float* rowss;
    DI void operator()(const f32x4 (&acc)[2][2][4][2], const Unit& u, int wr, int wc, int fr, int fq) const {
        const int rbase = u.pm * BM + wr * 64 + fr, cb = u.pn * BM + wc * 32 + 8 * fq;
#pragma unroll
        EPI_ROWS { const int row = rbase + ai * HALF + m * 16; float ss = 0.f;
#pragma unroll
            for (int bj = 0; bj < 2; ++bj) { const size_t off = (size_t)row * 1024 + cb + bj * HALF; f32x4 b0, b1;
                if (BASE_BF16) { const u32x4 bw = *(const u32x4*)(baseb + off); b0 = (f32x4){bf_lo(bw.x), bf_hi(bw.x), bf_lo(bw.y), bf_hi(bw.y)}; b1 = (f32x4){bf_lo(bw.z), bf_hi(bw.z), bf_lo(bw.w), bf_hi(bw.w)}; }
                else { b0 = *(const f32x4*)(basef + off); b1 = *(const f32x4*)(basef + off + 4); }
                const f32x4 h0 = b0 + acc[ai][bj][m][0], h1 = b1 + acc[ai][bj][m][1];
                *(u32x4*)(HB + off) = pack8(h0, h1);
                ss += (h0[0] * h0[0] + h0[1] * h0[1]) + (h0[2] * h0[2] + h0[3] * h0[3]) + (h1[0] * h1[0] + h1[1] * h1[1]) + (h1[2] * h1[2] + h1[3] * h1[3]); }
            ss += __shfl_xor(ss, 16); ss += __shfl_xor(ss, 32);
            if (fq == 0) unsafeAtomicAdd(rowss + row, ss); }
    }
};
struct EpiFF1 {
    static constexpr bool PERM = true, AFTER_DRAIN = false, HAS_MID = false;
    const float* rowss; bf16_t* HID;
    DI void operator()(const f32x4 (&acc)[2][2][4][2], const Unit& u, int wr, int wc, int fr, int fq) const {
        const int rbase = u.pm * BM + wr * 64 + fr, cb = u.pn * BM + wc * 32 + 8 * fq;
#pragma unroll
        EPI_ROWS { const int row = rbase + ai * HALF + m * 16; const float rs = __builtin_amdgcn_rsqf(rowss[row] * (1.0f / 1024.0f) + 1e-6f);
#pragma unroll
            for (int bj = 0; bj < 2; ++bj) { f32x4 t0 = acc[ai][bj][m][0] * rs, t1 = acc[ai][bj][m][1] * rs;
                t0 = __builtin_elementwise_max(t0, (f32x4){0.f, 0.f, 0.f, 0.f}); t1 = __builtin_elementwise_max(t1, (f32x4){0.f, 0.f, 0.f, 0.f});
                *(u32x4*)(HID + (size_t)row * 4096 + cb + bj * HALF) = pack8(t0 * t0, t1 * t1); } }
    }
};
struct EndOrder {
    int G, c;
    DI bool next(int i, Unit& u) const { const int L = i * G + c; if (L >= 128) return false; u.pm = L; u.pn = L >> 2; return true; }
    DI int kt(const Unit&, int ntf) const { return ntf; }
    DI size_t koff(const Unit&) const { return 0; }
    DI void a_ready(const Unit&) const {}
    DI void done(const Unit&) const {}
};
struct OutOrder {
    int G, c;
    DI bool next(int i, Unit& u) const { const int P = (i >> 1) * G + c; if (P >= 256) return false; const int g = P >> 3, pmq = (P & 7) >> 1, a = P & 1, pnq = (i & 1) ? a : 3 - a; u.pm = g * 4 + pmq; u.pn = g * 4 + pnq; return true; }
    DI int kt(const Unit& u, int) const { return 2 + 4 * ((u.pn & 3) + 1); }
    DI size_t koff(const Unit&) const { return 0; }
    DI void a_ready(const Unit&) const {}
    DI void done(const Unit&) const {}
};
struct MixOrder {
    StaticOrder B;
    DI bool next(int i, Unit& u) const { if (!B.next(i >> 1, u)) return false; u.seg = i & 1; return true; }
    DI int kt(const Unit&, int) const { return 8; }
    DI size_t koff(const Unit& u) const { return (size_t)u.seg * 1024; }
    DI bool partial(const Unit& u) const { return u.seg == 0; }
    DI void a_ready(const Unit&) const {}
    DI void done(const Unit&) const {}
};
}
using pg8::bf16_t; using pg8::bf16x8; using pg8::f32x4; using pg8::u32x4;
#define LAS __attribute__((address_space(3)))
constexpr int TOK = 65536, DM = 1024, SEQ = 4096, NCH = 64, NBC = 1024;
constexpr size_t MiB = 1u << 20;
constexpr size_t WS_ROWSS1 = 0, WS_ROWSS2 = 256 * 1024;
constexpr size_t WS_BAR = 512 * 1024, BAR_BYTES = 16384 + 256, WS_QCTR = WS_BAR + 14336, WS_PCNT = WS_BAR + 16384;
constexpr size_t WS_WIN = 1 * MiB, WS_WGLU = 9 * MiB, WS_WAB = 10 * MiB, WS_WOUT = 12 * MiB, WS_WFF1 = 14 * MiB, WS_WFF2 = 22 * MiB;
constexpr size_t WS_MCAT = 30 * MiB;
constexpr size_t WS_WEND = 102 * MiB;
constexpr size_t WS_SEND = 111 * MiB;
constexpr size_t WS_UC = 128 * MiB;
constexpr size_t WS_XN = 200 * MiB;
constexpr size_t WS_MIXED = 328 * MiB;
constexpr size_t WS_Q = 328 * MiB;
constexpr size_t WS_K = 392 * MiB;
constexpr size_t WS_VT = 456 * MiB;
constexpr size_t WS_GATES = 520 * MiB;
constexpr size_t WS_HB = 776 * MiB;
constexpr size_t WS_HID = 264 * MiB;
constexpr size_t WS_ATT = 904 * MiB;
constexpr size_t WS_H2B = 128 * MiB;
constexpr size_t WS_END = 968 * MiB;
constexpr int LDS_BYTES = 147456;
constexpr float LOG2E = 1.4426950408889634f;

struct Args { const float* in[21]; float* out; unsigned char* ws; int ph_lo, ph_hi; };

DI float wave_sum(float v) {
#pragma unroll
    for (int o = 1; o < 64; o <<= 1) v += __shfl_xor(v, o);
    return v;
}
DI void transpose_item(const float* W, int K, int N, bf16_t* WT, const float* sc, LAS float* scr, int k0, int n0, int sn0, int lane) {
    float wv[32];
#pragma unroll
    for (int i = 0; i < 32; ++i) wv[i] = W[(size_t)(k0 + 2 * i + (lane >> 5)) * N + sn0 + (lane & 31)];
#pragma unroll
    for (int i = 0; i < 32; ++i) { const int kk = 2 * i + (lane >> 5); float v = wv[i]; if (sc) v *= sc[k0 + kk]; scr[kk * 33 + (lane & 31)] = v; }
    asm volatile("s_waitcnt lgkmcnt(0)" ::: "memory");
    const int c = lane & 7;
#pragma unroll
    for (int j = 0; j < 4; ++j) { const int n = (lane >> 3) + 8 * j; const LAS float* s = scr + (8 * c) * 33 + n;
        u32x4 o; o.x = pkbf(s[0 * 33], s[1 * 33]); o.y = pkbf(s[2 * 33], s[3 * 33]); o.z = pkbf(s[4 * 33], s[5 * 33]); o.w = pkbf(s[6 * 33], s[7 * 33]);
        *(u32x4*)(WT + (size_t)(n0 + n) * K + k0 + 8 * c) = o; }
    asm volatile("s_waitcnt lgkmcnt(0)" ::: "memory");
}
constexpr int SL = 130;
DI void ssm_precompute(LAS unsigned char* lds, const Args& a, unsigned char* ws, int blk, int tid) {
    const int g = blk >> 2, r = blk & 3;
    LAS float* L = (LAS float*)lds; LAS float* Cc = L + 65 * SL + 2;     LAS float* Bb = Cc + 16 * SL; LAS bf16_t* KtR = (LAS bf16_t*)(Bb + 2048);
    const float *a_re = a.in[5], *a_im = a.in[6], *log_dt = a.in[7], *b_re = a.in[8], *b_im = a.in[9], *c_re = a.in[10], *c_im = a.in[11], *dsk = a.in[12];
    const double dt = exp((double)log_dt[g]);
    if (tid < 64) { const int p = tid; const double zr = (double)a_re[g * 64 + p] * dt, zi = (double)a_im[g * 64 + p] * dt;
        double s, c; sincos(zi, &s, &c); const double e = exp(zr); const double lr = e * c, li = e * s; double pr = 1.0, pi_ = 0.0;
        for (int d = 0; d < 65; ++d) { L[d * SL + p * 2] = (float)pr; L[d * SL + p * 2 + 1] = (float)pi_; const double nr = pr * lr - pi_ * li; pi_ = pr * li + pi_ * lr; pr = nr; } }
    for (int idx = tid; idx < 1024; idx += 512) { const int p = idx >> 4; const double ar = a_re[g * 64 + p], ai = a_im[g * 64 + p]; const double zr = ar * dt, zi = ai * dt;
        double s, c; sincos(zi, &s, &c); const double e = exp(zr); const double nr = e * c - 1.0, ni = e * s, den = ar * ar + ai * ai;
        const double qr = (nr * ar + ni * ai) / den, qi = (ni * ar - nr * ai) / den;
        const double br = b_re[g * 1024 + idx], bi = b_im[g * 1024 + idx];
        Bb[idx * 2] = (float)(qr * br - qi * bi); Bb[idx * 2 + 1] = (float)(qr * bi + qi * br);
        const int ch = idx >> 6, cp = idx & 63;
        Cc[ch * SL + cp * 2] = c_re[g * 1024 + idx]; Cc[ch * SL + cp * 2 + 1] = c_im[g * 1024 + idx]; }
    __syncthreads();
    {
        const int h = tid & 15, d0 = tid >> 4, d1 = d0 + 32;
        float acc0[16], acc1[16];
#pragma unroll
        for (int e = 0; e < 16; ++e) { acc0[e] = 0.f; acc1[e] = 0.f; }
        for (int p = 0; p < 64; ++p) { const f32x2 cv = *(const LAS f32x2*)(Cc + h * SL + p * 2), l0 = *(const LAS f32x2*)(L + d0 * SL + p * 2), l1 = *(const LAS f32x2*)(L + d1 * SL + p * 2);
            const float w0r = cv[0] * l0[0] - cv[1] * l0[1], w0i = cv[0] * l0[1] + cv[1] * l0[0], w1r = cv[0] * l1[0] - cv[1] * l1[1], w1i = cv[0] * l1[1] + cv[1] * l1[0];
            const LAS f32x4* bp = (const LAS f32x4*)(Bb + p * 32);
#pragma unroll
            for (int e2 = 0; e2 < 8; ++e2) { const f32x4 bb = bp[e2];
                acc0[2 * e2] += w0r * bb[0] - w0i * bb[1]; acc0[2 * e2 + 1] += w0r * bb[2] - w0i * bb[3];
                acc1[2 * e2] += w1r * bb[0] - w1i * bb[1]; acc1[2 * e2 + 1] += w1r * bb[2] - w1i * bb[3]; } }
        if (d0 == 0) {
#pragma unroll
            for (int e = 0; e < 16; ++e) if (e == h) acc0[e] += dsk[g * 16 + h]; }
        u32x4 w0a, w0b, w1a, w1b;
        w0a.x = pkbf(acc0[0], acc0[1]); w0a.y = pkbf(acc0[2], acc0[3]); w0a.z = pkbf(acc0[4], acc0[5]); w0a.w = pkbf(acc0[6], acc0[7]);
        w0b.x = pkbf(acc0[8], acc0[9]); w0b.y = pkbf(acc0[10], acc0[11]); w0b.z = pkbf(acc0[12], acc0[13]); w0b.w = pkbf(acc0[14], acc0[15]);
        w1a.x = pkbf(acc1[0], acc1[1]); w1a.y = pkbf(acc1[2], acc1[3]); w1a.z = pkbf(acc1[4], acc1[5]); w1a.w = pkbf(acc1[6], acc1[7]);
        w1b.x = pkbf(acc1[8], acc1[9]); w1b.y = pkbf(acc1[10], acc1[11]); w1b.z = pkbf(acc1[12], acc1[13]); w1b.w = pkbf(acc1[14], acc1[15]);
        LAS u32x4* k0 = (LAS u32x4*)(KtR + (h * 64 + 63 - d0) * 16); LAS u32x4* k1 = (LAS u32x4*)(KtR + (h * 64 + 63 - d1) * 16);
        k0[0] = w0a; k0[1] = w0b; k1[0] = w1a; k1[1] = w1b;
    }
    __syncthreads();
    bf16_t* Mg = (bf16_t*)(ws + WS_MCAT) + (size_t)g * 1024 * 1152;
    for (int idx = tid; idx < 256 * 128; idx += 512) { const int rl = idx >> 7, qt = idx & 127, n = r * 256 + rl, i = n >> 4, h = n & 15;
        u32x4 w = {0u, 0u, 0u, 0u};
        if ((qt >> 1) <= i) w = *(const LAS u32x4*)(KtR + (h * 64 + 63 - i) * 16 + qt * 8);
        *(u32x4*)(Mg + (size_t)n * 1152 + 128 + qt * 8) = w; }
    for (int idx = tid; idx < 256 * 64; idx += 512) { const int rl = idx >> 6, pp = idx & 63, n = r * 256 + rl, i = n >> 4, h = n & 15, p = (2 * pp) & 63; const bool im = pp >= 32;
        const f32x2 c0 = *(const LAS f32x2*)(Cc + h * SL + p * 2), c1 = *(const LAS f32x2*)(Cc + h * SL + p * 2 + 2), l0 = *(const LAS f32x2*)(L + (i + 1) * SL + p * 2), l1 = *(const LAS f32x2*)(L + (i + 1) * SL + p * 2 + 2);
        const float v0 = im ? -(c0[0] * l0[1] + c0[1] * l0[0]) : (c0[0] * l0[0] - c0[1] * l0[1]), v1 = im ? -(c1[0] * l1[1] + c1[1] * l1[0]) : (c1[0] * l1[0] - c1[1] * l1[1]);
        *(unsigned*)(Mg + (size_t)n * 1152 + 2 * pp) = pkbf(v0, v1); }
    bf16_t* Wg = (bf16_t*)(ws + WS_WEND) + (size_t)g * 128 * 1024;
    for (int idx = tid; idx < 32 * 128; idx += 512) { const int rl = idx >> 7, q = idx & 127, n = r * 32 + rl, p = n & 63, j = q >> 1, h0 = (q & 1) * 8; const bool im = n >= 64;
        const float lr = L[(63 - j) * SL + p * 2], li = L[(63 - j) * SL + p * 2 + 1]; f32x4 v0, v1;
#pragma unroll
        for (int e = 0; e < 8; ++e) { const float br = Bb[(p * 16 + h0 + e) * 2], bi = Bb[(p * 16 + h0 + e) * 2 + 1]; const float val = im ? (lr * bi + li * br) : (lr * br - li * bi); if (e < 4) v0[e] = val; else v1[e - 4] = val; }
        *(u32x4*)(Wg + (size_t)n * 1024 + q * 8) = pg8::pack8(v0, v1); }
    __syncthreads();
}
DI void prologue(LAS unsigned char* lds, const Args& a, unsigned char* ws, int blk, int G, int tid) {
    const int lane = tid & 63, wave = tid >> 6;
    float* rss = (float*)(ws + WS_ROWSS1);
    for (int i = blk * 512 + tid; i < 2 * TOK; i += G * 512) rss[i] = 0.f;
    for (int sb = blk; sb < 128; sb += G) ssm_precompute(lds, a, ws, sb, tid);
    LAS float* scr = (LAS float*)(lds + wave * 16384);
    constexpr int I_IN = 16 * 128, I_GLU = 8 * 32, I_A = 8 * 32, I_B = 8 * 32, I_OUT = 16 * 32, I_F1 = 16 * 128, I_F2 = 64 * 32;
    constexpr int NITEMS = I_IN + I_GLU + I_A + I_B + I_OUT + I_F1 + I_F2, NXN = TOK / 16;
    unsigned* qctr = (unsigned*)(ws + WS_QCTR);
    const float* x = a.in[0]; const f32x4* gm = (const f32x4*)a.in[1] + lane; bf16_t* XN = (bf16_t*)(ws + WS_XN);
    int shard_i = 0;
    for (;;) {
        const int shard = (blk + shard_i) & 7;
        int it = 0; if (lane == 0) it = (int)__hip_atomic_fetch_add(qctr + shard * 64, 1u, __ATOMIC_RELAXED, __HIP_MEMORY_SCOPE_AGENT);
        it = __builtin_amdgcn_readfirstlane(it) * 8 + shard;
        if (it >= NITEMS + NXN) { if (++shard_i == 8) break; continue; }
        if (it >= NITEMS) {
            const int m0 = (it - NITEMS) * 16;
            f32x4 gv[4];
#pragma unroll
            for (int j = 0; j < 4; ++j) gv[j] = gm[64 * j];
            for (int mb = m0; mb < m0 + 16; mb += 4) {
                f32x4 v[4][4];
#pragma unroll
                for (int r = 0; r < 4; ++r) { const f32x4* xr = (const f32x4*)(x + (size_t)(mb + r) * DM) + lane;
#pragma unroll
                    for (int j = 0; j < 4; ++j) v[r][j] = xr[64 * j]; }
#pragma unroll
                for (int r = 0; r < 4; ++r) { float s = 0.f;
#pragma unroll
                    for (int j = 0; j < 4; ++j) s += (v[r][j][0] * v[r][j][0] + v[r][j][1] * v[r][j][1]) + (v[r][j][2] * v[r][j][2] + v[r][j][3] * v[r][j][3]);
                    const float rs = 1.0f / sqrtf(wave_sum(s) * (1.0f / DM) + 1e-6f);
                    u32x2* o8 = (u32x2*)(XN + (size_t)(mb + r) * DM) + lane;
#pragma unroll
                    for (int j = 0; j < 4; ++j) { const f32x4 t = v[r][j] * rs * gv[j]; u32x2 w; w.x = pkbf(t[0], t[1]); w.y = pkbf(t[2], t[3]); o8[64 * j] = w; } } }
            continue;
        }
        int rr = it;
        if (rr < I_IN) { transpose_item(a.in[2], 1024, 4096, (bf16_t*)(ws + WS_WIN), nullptr, scr, 64 * (rr / 128), 32 * (rr % 128), 32 * (rr % 128), lane); continue; } rr -= I_IN;
        if (rr < I_GLU) { const int n0 = 32 * (rr % 32), sn0 = ((n0 & 255) >> 7) * 512 + 128 * (n0 >> 8) + (n0 & 127);
            transpose_item(a.in[13], 512, 1024, (bf16_t*)(ws + WS_WGLU), nullptr, scr, 64 * (rr / 32), n0, sn0, lane); continue; } rr -= I_GLU;
        if (rr < I_A) { transpose_item(a.in[14], 1024, 1024, (bf16_t*)(ws + WS_WAB), nullptr, scr, 64 * (rr / 32), 32 * (rr % 32), 32 * (rr % 32), lane); continue; } rr -= I_A;
        if (rr < I_B) { transpose_item(a.in[15], 1024, 1024, (bf16_t*)(ws + WS_WAB) + 512, nullptr, scr, 64 * (rr / 32), 32 * (rr % 32), 32 * (rr % 32), lane); continue; } rr -= I_B;
        if (rr < I_OUT) { transpose_item(a.in[16], 1024, 1024, (bf16_t*)(ws + WS_WOUT), nullptr, scr, 64 * (rr / 32), 32 * (rr % 32), 32 * (rr % 32), lane); continue; } rr -= I_OUT;
        if (rr < I_F1) { transpose_item(a.in[18], 1024, 4096, (bf16_t*)(ws + WS_WFF1), a.in[17], scr, 64 * (rr / 128), 32 * (rr % 128), 32 * (rr % 128), lane); continue; } rr -= I_F1;
        transpose_item(a.in[19], 4096, 1024, (bf16_t*)(ws + WS_WFF2), nullptr, scr, 64 * (rr / 32), 32 * (rr % 32), 32 * (rr % 32), lane);
    }
    __syncthreads();
}
#define MFMA32(a, b, c) __builtin_amdgcn_mfma_f32_32x32x16_bf16((a), (b), (c), 0, 0, 0)
DI int crow(int reg, int hh) { return (reg & 3) + 8 * (reg >> 2) + 4 * hh; }
constexpr int AT_KROW = 144, AT_VROW = 136, AT_KBUF = 64 * AT_KROW, AT_VBUF = 64 * AT_VROW, AT_SEL = AT_KBUF + AT_VBUF, AT_PAR = 2 * AT_SEL, AT_BIAS = 2 * AT_PAR, AT_UQ = AT_BIAS + 2048, AT_TILES = 77824;
DI float max16(const f32x16& S) { float m = fmaxf(S[0], S[1]);
#pragma unroll
    for (int e = 2; e < 16; e += 2) m = fmaxf(fmaxf(m, S[e]), S[e + 1]);
    return m; }
DI float exp_sum16(f32x16& S) { f32x2 a = {0.f, 0.f};
#pragma unroll
    for (int e = 0; e < 16; e += 2) { S[e] = __builtin_amdgcn_exp2f(S[e]); S[e + 1] = __builtin_amdgcn_exp2f(S[e + 1]); a += (f32x2){S[e], S[e + 1]}; }
    return a[0] + a[1]; }
DI bf16x8 pack_half(const f32x16& S, int s2) { u32x4 pw; pw.x = pkbf(S[8 * s2], S[8 * s2 + 1]); pw.y = pkbf(S[8 * s2 + 2], S[8 * s2 + 3]); pw.z = pkbf(S[8 * s2 + 4], S[8 * s2 + 5]); pw.w = pkbf(S[8 * s2 + 6], S[8 * s2 + 7]); return __builtin_bit_cast(bf16x8, pw); }
DI void attn_phase(LAS unsigned char* lds, const bf16_t* Q, bf16_t* ATT, const bf16_t* Kb, const bf16_t* VT, const float* rel_bias, unsigned* actr, int tid) {
    const int wave = tid >> 6, lane = tid & 63, c32 = lane & 31, hh = lane >> 5, sel = wave >> 2;
    LAS float* bt = (LAS float*)(lds + AT_BIAS); volatile LAS int* uq = (volatile LAS int*)(lds + AT_UQ);
    const int ssel = tid >> 8, srow = (tid & 255) >> 3, spc = tid & 7;
    __syncthreads();
    if (tid == 0) uq[0] = (int)__hip_atomic_fetch_add(actr, 1u, __ATOMIC_RELAXED, __HIP_MEMORY_SCOPE_AGENT);
    __syncthreads();
    int cur = uq[0];
    while (cur < 1024) {
        int nxt_ticket = 0;
        if (tid == 0) nxt_ticket = (int)__hip_atomic_fetch_add(actr, 1u, __ATOMIC_RELAXED, __HIP_MEMORY_SCOPE_AGENT);
        const int rank = cur >> 6, bp = (cur & 63) >> 3, h = cur & 7, gidx = rank < 14 ? rank + 2 : 15 - rank, n0 = gidx * 4;
        if (tid < 257) bt[tid] = rel_bias[h * 257 + tid] * LOG2E;
        __syncthreads();
        {
            LAS float* BT = (LAS float*)(lds + AT_TILES);
            for (int idx = tid; idx < 7 * 1024; idx += 512) { const int t = idx >> 10, q = (idx >> 8) & 3, ln = (idx >> 2) & 63, r = idx & 3;
                int id = 32 * t - 32 + (ln & 31) - crow(4 * q + r, ln >> 5) + 128; id = id < 0 ? 0 : (id > 256 ? 256 : id); BT[idx] = bt[id]; }
        }
        const int bw = bp + 8 * sel, bs = bp + 8 * ssel, n = n0 + (wave & 3);
        const bf16_t* kg = Kb + ((size_t)bs * SEQ + srow) * 512 + h * 64 + spc * 8;
        const bf16_t* vg = VT + ((size_t)((bs * 8 + h) * 64 + srow)) * 4096 + spc * 8;
        const int kc_lo = n0 >= 8 ? n0 - 8 : 0, kc_hi = n0 + 3;
        const size_t tok0 = (size_t)bw * SEQ + n * 64 + c32;
        bf16x8 qf0[4], qf1[4];
#pragma unroll
        for (int s = 0; s < 4; ++s) { qf0[s] = *(const bf16x8*)(Q + tok0 * 512 + h * 64 + 32 * hh + 8 * s); qf1[s] = *(const bf16x8*)(Q + (tok0 + 32) * 512 + h * 64 + 32 * hh + 8 * s); }
        f32x16 O00, O01, O10, O11;
#pragma unroll
        for (int e = 0; e < 16; ++e) { O00[e] = 0.f; O01[e] = 0.f; O10[e] = 0.f; O11[e] = 0.f; }
        float mref0 = 0.f, mref1 = 0.f, lsum0 = 0.f, lsum1 = 0.f; bool fresh = true;
        u32x4 k0r = *(const u32x4*)(kg + (size_t)kc_lo * 64 * 512), k1r = *(const u32x4*)(kg + (size_t)kc_lo * 64 * 512 + 32 * 512), v0r = *(const u32x4*)(vg + kc_lo * 64), v1r = *(const u32x4*)(vg + kc_lo * 64 + 32 * 4096);
        for (int kc = kc_lo; kc <= kc_hi; ++kc) {
            LAS unsigned char* base = lds + ((kc - kc_lo) & 1) * AT_PAR;
            { LAS unsigned char* kw = base + ssel * AT_SEL; LAS unsigned char* vw = kw + AT_KBUF;
              *(LAS u32x4*)(kw + srow * AT_KROW + spc * 16) = k0r; *(LAS u32x4*)(kw + (srow + 32) * AT_KROW + spc * 16) = k1r;
              *(LAS u32x2*)(vw + srow * AT_VROW + spc * 16) = (u32x2){v0r.x, v0r.y}; *(LAS u32x2*)(vw + srow * AT_VROW + spc * 16 + 8) = (u32x2){v0r.z, v0r.w};
              *(LAS u32x2*)(vw + (srow + 32) * AT_VROW + spc * 16) = (u32x2){v1r.x, v1r.y}; *(LAS u32x2*)(vw + (srow + 32) * AT_VROW + spc * 16 + 8) = (u32x2){v1r.z, v1r.w}; }
            __syncthreads();
            if (kc < kc_hi) { const size_t ko = (size_t)(kc + 1) * 64 * 512; k0r = *(const u32x4*)(kg + ko); k1r = *(const u32x4*)(kg + ko + 32 * 512); v0r = *(const u32x4*)(vg + (kc + 1) * 64); v1r = *(const u32x4*)(vg + (kc + 1) * 64 + 32 * 4096); }
            const int delta = n - kc;
            if (delta >= 0 && delta <= 8) {
                const LAS unsigned char* kb_ = base + sel * AT_SEL; const LAS unsigned char* vb_ = kb_ + AT_KBUF;
#pragma unroll
                for (int kt = 0; kt < 2; ++kt) {
                    f32x16 S0, S1;
                    if (delta >= 3) { const float cf = bt[256], c0 = cf - mref0, c1 = cf - mref1;
#pragma unroll
                        for (int e = 0; e < 16; ++e) { S0[e] = c0; S1[e] = c1; }
                    } else { const LAS f32x4* t0p = (const LAS f32x4*)(lds + AT_TILES) + (2 * delta - kt + 1) * 256 + lane; const LAS f32x4* t1p = t0p + 256;
#pragma unroll
                        for (int q = 0; q < 4; ++q) { const f32x4 ta = t0p[q * 64], tb = t1p[q * 64];
#pragma unroll
                            for (int r = 0; r < 4; ++r) { S0[4 * q + r] = ta[r] - mref0; S1[4 * q + r] = tb[r] - mref1; } }
                    }
                    const LAS unsigned char* kp = kb_ + (32 * kt + c32) * AT_KROW + 64 * hh;
#pragma unroll
                    for (int s = 0; s < 4; ++s) { const bf16x8 kf = *(const LAS bf16x8*)(kp + 16 * s); S0 = MFMA32(kf, qf0[s], S0); S1 = MFMA32(kf, qf1[s], S1); }
                    float cm0 = max16(S0), cm1 = max16(S1);
                    cm0 = fmaxf(cm0, __shfl_xor(cm0, 32)); cm1 = fmaxf(cm1, __shfl_xor(cm1, 32));
                    if (fresh || __any(fmaxf(cm0, cm1) > 20.0f)) {
                        const float d0 = (fresh || cm0 > 20.0f) ? cm0 : 0.f, d1 = (fresh || cm1 > 20.0f) ? cm1 : 0.f;
                        const float s0 = fresh ? 1.0f : __builtin_amdgcn_exp2f(-d0), s1 = fresh ? 1.0f : __builtin_amdgcn_exp2f(-d1);
                        mref0 += d0; mref1 += d1; lsum0 *= s0; lsum1 *= s1;
#pragma unroll
                        for (int e = 0; e < 16; ++e) { S0[e] -= d0; S1[e] -= d1; O00[e] *= s0; O10[e] *= s0; O01[e] *= s1; O11[e] *= s1; }
                        fresh = false;
                    }
                    lsum0 += exp_sum16(S0); lsum1 += exp_sum16(S1);
                    const LAS unsigned char* vp = vb_ + c32 * AT_VROW + 8 * hh + 64 * kt;
#pragma unroll
                    for (int s2 = 0; s2 < 2; ++s2) {
                        const bf16x8 p0 = pack_half(S0, s2), p1 = pack_half(S1, s2);
                        const LAS unsigned char* v0p = vp + 32 * s2;
                        const s16x4 a0 = *(const LAS s16x4*)v0p, a1 = *(const LAS s16x4*)(v0p + 16), c0 = *(const LAS s16x4*)(v0p + 32 * AT_VROW), c1 = *(const LAS s16x4*)(v0p + 32 * AT_VROW + 16);
                        const bf16x8 vf0 = {a0[0], a0[1], a0[2], a0[3], a1[0], a1[1], a1[2], a1[3]}, vf1 = {c0[0], c0[1], c0[2], c0[3], c1[0], c1[1], c1[2], c1[3]};
                        O00 = MFMA32(vf0, p0, O00); O01 = MFMA32(vf0, p1, O01); O10 = MFMA32(vf1, p0, O10); O11 = MFMA32(vf1, p1, O11);
                    }
                }
            }
        }
        lsum0 += __shfl_xor(lsum0, 32); lsum1 += __shfl_xor(lsum1, 32);
        const float inv0 = 1.0f / lsum0, inv1 = 1.0f / lsum1;
        bf16_t* op0 = ATT + tok0 * 1024 + h * 64 + 4 * hh; bf16_t* op1 = op0 + 32 * 1024;
#pragma unroll
        for (int gq = 0; gq < 4; ++gq) { u32x2 w;
            w.x = pkbf(O00[4 * gq] * inv0, O00[4 * gq + 1] * inv0); w.y = pkbf(O00[4 * gq + 2] * inv0, O00[4 * gq + 3] * inv0); *(u32x2*)(op0 + 8 * gq) = w;
            w.x = pkbf(O10[4 * gq] * inv0, O10[4 * gq + 1] * inv0); w.y = pkbf(O10[4 * gq + 2] * inv0, O10[4 * gq + 3] * inv0); *(u32x2*)(op0 + 32 + 8 * gq) = w;
            w.x = pkbf(O01[4 * gq] * inv1, O01[4 * gq + 1] * inv1); w.y = pkbf(O01[4 * gq + 2] * inv1, O01[4 * gq + 3] * inv1); *(u32x2*)(op1 + 8 * gq) = w;
            w.x = pkbf(O11[4 * gq] * inv1, O11[4 * gq + 1] * inv1); w.y = pkbf(O11[4 * gq + 2] * inv1, O11[4 * gq + 3] * inv1); *(u32x2*)(op1 + 32 + 8 * gq) = w; }
        if (tid == 0) uq[0] = nxt_ticket;
        __syncthreads();
        cur = uq[0];
    }
    __syncthreads();
}
DI void carry_scan(const Args& a, unsigned char* ws, int blk, int G, int tid) {
    const float* SEND = (const float*)(ws + WS_SEND); bf16_t* UC = (bf16_t*)(ws + WS_UC);
    if (tid < 128)
    for (int idx = blk * 128 + tid; idx < 32768; idx += G * 128) {
        const int p = idx & 63, g = (idx >> 6) & 31, b = idx >> 11;
        const float* sp = SEND + ((size_t)(b * 64) * 32 + g) * 128 + p;
        float sr[64], si[64];
#pragma unroll
        for (int ch = 0; ch < 64; ++ch) { sr[ch] = sp[(size_t)ch * 4096]; si[ch] = sp[(size_t)ch * 4096 + 64]; }
        const double dt = exp((double)a.in[7][g]); const double zr = (double)a.in[5][g * 64 + p] * dt * 64.0, zi = (double)a.in[6][g * 64 + p] * dt * 64.0;
        double s, c; sincos(zi, &s, &c); const double e = exp(zr); const float lr = (float)(e * c), li = (float)(e * s);
        float cr = 0.f, ci = 0.f;
        bf16_t* up = UC + ((size_t)(g * 1024 + b * 64)) * 1152 + p;
#pragma unroll
        for (int ch = 0; ch < 64; ++ch) { const unsigned w = pkbf(cr, ci); up[(size_t)ch * 1152] = (bf16_t)(w & 0xffffu); up[(size_t)ch * 1152 + 64] = (bf16_t)(w >> 16);
            const float nr = lr * cr - li * ci + sr[ch], ni = lr * ci + li * cr + si[ch]; cr = nr; ci = ni; }
    }
}
DI void final_norm(const Args& a, unsigned char* ws, int blk, int G, int tid) {
    const int lane = tid & 63, wave = tid >> 6, gw = blk * 8 + wave, NGW = G * 8;
    const float* rss = (const float*)(ws + WS_ROWSS2); const bf16_t* H2B = (const bf16_t*)(ws + WS_H2B);
    const f32x4* gm = (const f32x4*)a.in[20] + 2 * lane;
    f32x4 gv[2][2];
#pragma unroll
    for (int j = 0; j < 2; ++j) { gv[j][0] = gm[128 * j]; gv[j][1] = gm[128 * j + 1]; }
    for (int m = gw; m < TOK; m += 4 * NGW) {
        u32x4 w[4][2]; float rs[4];
#pragma unroll
        for (int r = 0; r < 4; ++r) { const int mm = m + r * NGW; if (mm < TOK) { const u32x4* hp = (const u32x4*)(H2B + (size_t)mm * DM) + lane; w[r][0] = hp[0]; w[r][1] = hp[64]; rs[r] = rss[mm]; } }
#pragma unroll
        for (int r = 0; r < 4; ++r) { const int mm = m + r * NGW; if (mm < TOK) { const float sc = 1.0f / sqrtf(rs[r] * (1.0f / DM) + 1e-6f); f32x4* o = (f32x4*)(a.out + (size_t)mm * DM) + 2 * lane;
#pragma unroll
            for (int j = 0; j < 2; ++j) { const u32x4 ww = w[r][j];
                o[128 * j] = (f32x4){bf_lo(ww.x), bf_hi(ww.x), bf_lo(ww.y), bf_hi(ww.y)} * sc * gv[j][0]; o[128 * j + 1] = (f32x4){bf_lo(ww.z), bf_hi(ww.z), bf_lo(ww.w), bf_hi(ww.w)} * sc * gv[j][1]; } } } }
}
#define XB_TMO      128
#define XB_XCNT(j)  (256  + 64 * (j))
#define XB_XSUB(j)  (1280 + 64 * (j))
#define XB_XGEN(j)  (2304 + 64 * (j))
#define XB_TOP      3328
#define XB_TOPGEN   3392
#define XCD_BAR_WORDS 3456
#define XB_SPIN_CAP (1u << 18)

__device__ __forceinline__ unsigned xb_ld(unsigned* p)              { return __hip_atomic_load(p, __ATOMIC_RELAXED, __HIP_MEMORY_SCOPE_AGENT); }
__device__ __forceinline__ unsigned xb_add(unsigned* p, unsigned v) { return __hip_atomic_fetch_add(p, v, __ATOMIC_RELAXED, __HIP_MEMORY_SCOPE_AGENT); }
__device__ __forceinline__ unsigned xb_xcc_id() { return (unsigned)__builtin_amdgcn_s_getreg((3 << 11) | 20) & 0xFu; }
#define XB_SPIN(cond, bar) do { unsigned _sp = 0; while (cond) { __builtin_amdgcn_s_sleep(1); \
    if ((++_sp & 255u) == 0u) { if (xb_ld(&(bar)[XB_TMO])) break; if (_sp > XB_SPIN_CAP) { atomicAdd(&(bar)[XB_TMO], 1u); break; } } } } while (0)

struct XcdBarrier {
    unsigned* bar; unsigned x;
    volatile LAS unsigned* st;
};

__device__ __forceinline__ XcdBarrier xcd_barrier_post(unsigned* bar, volatile LAS unsigned* st) {
    XcdBarrier b; b.bar = bar; b.x = xb_xcc_id(); b.st = st;
    if (threadIdx.x == 0) (void)xb_add(&bar[XB_XCNT(b.x)], 1u);
    return b;
}
__device__ __forceinline__ void xcd_barrier_complete(unsigned* bar, unsigned x, unsigned& nloc, unsigned& nx) {
    const unsigned G = gridDim.x * gridDim.y * gridDim.z;
    unsigned sum, cnt, mine, sp = 0u;
    for (;;) {
        sum = 0u; cnt = 0u; mine = 0u;
#pragma unroll
        for (unsigned j = 0; j < 16; ++j) { const unsigned c = xb_ld(&bar[XB_XCNT(j)]); sum += c; cnt += (c > 0u) ? 1u : 0u; mine = (j == x) ? c : mine; }
        if (sum == G) break;
        __builtin_amdgcn_s_sleep(1);
        if ((++sp & 255u) == 0u) { if (xb_ld(&bar[XB_TMO])) break; if (sp > XB_SPIN_CAP) { atomicAdd(&bar[XB_TMO], 1u); break; } }
    }
    nloc = mine > 0u ? mine : 1u; nx = cnt > 0u ? cnt : 1u;
}

__device__ __forceinline__ void xcd_barrier(const XcdBarrier& b) {
    asm volatile("s_waitcnt vmcnt(0)" ::: "memory");
    __syncthreads();
    if (threadIdx.x == 0) {
        unsigned* bar = b.bar;
        __builtin_amdgcn_s_waitcnt(0);
        unsigned nloc = b.st[0], nx = b.st[1];
        if (nloc == 0u) { xcd_barrier_complete(bar, b.x, nloc, nx); b.st[0] = nloc; b.st[1] = nx; }
        const unsigned old = xb_add(&bar[XB_XSUB(b.x)], 1u);
        const unsigned gen = old / nloc;
        if (old + 1u == (gen + 1u) * nloc) {
            __builtin_amdgcn_fence(__ATOMIC_RELEASE, "agent");
            asm volatile("s_waitcnt vmcnt(0)" ::: "memory");
            const unsigned og = xb_add(&bar[XB_TOP], 1u);
            const unsigned tg = og / nx;
            if (og + 1u == (tg + 1u) * nx) xb_add(&bar[XB_TOPGEN], 1u);
            else XB_SPIN(xb_ld(&bar[XB_TOPGEN]) == tg, bar);
            __builtin_amdgcn_fence(__ATOMIC_ACQUIRE, "agent");
            xb_add(&bar[XB_XGEN(b.x)], 1u);
            asm volatile("s_waitcnt vmcnt(0)" ::: "memory");
        } else {
            XB_SPIN(xb_ld(&bar[XB_XGEN(b.x)]) == gen, bar);
            __builtin_amdgcn_fence(__ATOMIC_ACQUIRE, "agent");
            asm volatile("s_waitcnt vmcnt(0)" ::: "memory");
        }
    }
    __syncthreads();
}

#ifndef WGM_P1
#define WGM_P1 5
#endif
#ifndef WGM_P8
#define WGM_P8 10
#endif
#ifndef WGM_P9
#define WGM_P9 8
#endif
#ifndef WGM_PN
#define WGM_PN 8
#endif
constexpr int N_PHASES = 11;
constexpr int LDS_BARST = 131072 + 64;
template <bool COOP> __global__ void __launch_bounds__(512, 2) fwd(Args a) {
    extern __shared__ __attribute__((aligned(16))) unsigned char lds_raw[];
    LAS unsigned char* lds = (LAS unsigned char*)lds_raw;
    const int tid = threadIdx.x, blk = blockIdx.x, G = gridDim.x; unsigned char* ws = a.ws;
    const int lo = a.ph_lo, hi = a.ph_hi;
#ifndef PROBE_PHASE
#define PROBE_PHASE -1
#endif
#define IN(k) (lo <= (k) && (k) < hi)
#define REP(k) for (int rep_ = 0; rep_ < ((k) == PROBE_PHASE ? 2 : 1); ++rep_)
#define SEAM(k) do { if constexpr (COOP) { if (IN(k) && IN((k) + 1)) xcd_barrier(bar); } } while (0)
    bf16_t *WIN = (bf16_t*)(ws + WS_WIN), *WGLU = (bf16_t*)(ws + WS_WGLU), *WAB = (bf16_t*)(ws + WS_WAB), *WOUT = (bf16_t*)(ws + WS_WOUT), *WFF1 = (bf16_t*)(ws + WS_WFF1), *WFF2 = (bf16_t*)(ws + WS_WFF2);
    bf16_t *MCAT = (bf16_t*)(ws + WS_MCAT), *WEND = (bf16_t*)(ws + WS_WEND), *UC = (bf16_t*)(ws + WS_UC), *XN = (bf16_t*)(ws + WS_XN), *AG = XN, *MIXED = (bf16_t*)(ws + WS_MIXED), *Qb = (bf16_t*)(ws + WS_Q), *Kb = (bf16_t*)(ws + WS_K), *YS = Kb;
    bf16_t *VT = (bf16_t*)(ws + WS_VT), *GATES = (bf16_t*)(ws + WS_GATES), *HB = (bf16_t*)(ws + WS_HB), *HID = (bf16_t*)(ws + WS_HID);
    float *SEND = (float*)(ws + WS_SEND), *RSS1 = (float*)(ws + WS_ROWSS1), *RSS2 = (float*)(ws + WS_ROWSS2);
    using namespace pg8;
    XcdBarrier bar; bar.bar = (unsigned*)(ws + WS_BAR); bar.x = 0; bar.st = (volatile LAS unsigned*)(lds + LDS_BARST);
    if constexpr (COOP) {
        if (tid == 0) { bar.st[0] = 0u; bar.st[1] = 0u; }
        __syncthreads();
        bar = xcd_barrier_post((unsigned*)(ws + WS_BAR), (volatile LAS unsigned*)(lds + LDS_BARST));
        if (hi > N_PHASES) cg::this_grid().sync();
    }
    if (IN(0)) REP(0) { prologue(lds, a, ws, blk, G, tid); }
    SEAM(0);
    if (IN(1)) REP(1) { Gemm g{XN, WIN, 1024, 1024, 1024, 256}; StaticOrder S; S.init(TOK, 4096, G, blk, WGM_P1); EpiIn E{Qb, Kb, VT, UC, GATES, a.in[3]};
        gemm_phase<EpiIn, StaticOrder, true, true>(lds, g, S, E); }
    SEAM(1);
    if (IN(2)) REP(2) { { Gemm g{UC + 128, WEND, 1024, 1152, 1024, 128}; EndOrder S{G, blk}; EpiSend E{SEND}; gemm_phase<EpiSend, EndOrder, true, true>(lds, g, S, E); }
        attn_phase(lds, Qb, AG, Kb, VT, a.in[4], (unsigned*)(ws + WS_PCNT), tid);
#if PROBE_PHASE == 22
        if constexpr (COOP) { xcd_barrier(bar); if (blk == 0 && tid == 0) __hip_atomic_store((unsigned*)(ws + WS_PCNT), 0u, __ATOMIC_RELAXED, __HIP_MEMORY_SCOPE_AGENT); xcd_barrier(bar);
            attn_phase(lds, Qb, AG, Kb, VT, a.in[4], (unsigned*)(ws + WS_PCNT), tid); }
#endif
        }
    SEAM(2);
    if (IN(3)) REP(3) { carry_scan(a, ws, blk, G, tid); }
    SEAM(3);
    if (IN(4)) REP(4) { Gemm g{UC, MCAT, 1152, 1152, 1152, 256}; OutOrder S{G, blk}; EpiSsmOut E{YS}; gemm_phase<EpiSsmOut, OutOrder, true, true>(lds, g, S, E); }
    SEAM(4);
    if (IN(5)) REP(5) { Gemm g{YS, WGLU, 512, 512, 512, 256}; StaticOrder S; S.init(TOK, 1024, G, blk, WGM_PN); EpiGlu E{AG}; gemm_phase<EpiGlu, StaticOrder, true, true>(lds, g, S, E); }
    SEAM(5);
    if (IN(6)) REP(6) { Gemm g{AG, WAB, 1024, 1024, 1024, 256}; MixOrder S; S.B.init(TOK, 1024, G, blk, WGM_PN); EpiMix E{GATES, MIXED}; gemm_phase<EpiMix, MixOrder, true, true>(lds, g, S, E); }
    SEAM(6);
    if (IN(7)) REP(7) { Gemm g{MIXED, WOUT, 1024, 1024, 1024, 256}; StaticOrder S; S.init(TOK, 1024, G, blk, WGM_PN); EpiResid<false> E{a.in[0], nullptr, HB, RSS1};
        gemm_phase<EpiResid<false>, StaticOrder, true, true>(lds, g, S, E); }
    SEAM(7);
    if (IN(8)) REP(8) { Gemm g{HB, WFF1, 1024, 1024, 1024, 256}; StaticOrder S; S.init(TOK, 4096, G, blk, WGM_P8); EpiFF1 E{RSS1, HID}; gemm_phase<EpiFF1, StaticOrder, true, true>(lds, g, S, E); }
    SEAM(8);
    if (IN(9)) REP(9) { Gemm g{HID, WFF2, 4096, 4096, 4096, 256}; StaticOrder S; S.init(TOK, 1024, G, blk, WGM_P9); EpiResid<true> E{nullptr, HB, (bf16_t*)(ws + WS_H2B), RSS2};
        gemm_phase<EpiResid<true>, StaticOrder, true, true>(lds, g, S, E); }
    SEAM(9);
    if (IN(10)) REP(10) { final_norm(a, ws, blk, G, tid); }
#undef IN
#undef SEAM
}
extern "C" void kernel_launch(void* const* d_in, const int* in_sizes, int n_in, void* d_out, int out_size, void* d_ws, size_t ws_size, hipStream_t stream) {
    static int grid = 0;
    if (grid == 0) {
        if (n_in != 21 || in_sizes[0] != TOK * DM || out_size != TOK * DM || ws_size < WS_END) { fprintf(stderr, "kernel_launch: unexpected shapes (n_in %d, in0 %d, out %d, ws %zu)\n", n_in, n_in > 0 ? in_sizes[0] : -1, out_size, ws_size); grid = -1; return; }
        int dev = 0, cus = 0, per_cu = 0;
        hipGetDevice(&dev); hipDeviceGetAttribute(&cus, hipDeviceAttributeMultiprocessorCount, dev);
        hipFuncSetAttribute((const void*)fwd<true>, hipFuncAttributeMaxDynamicSharedMemorySize, LDS_BYTES);
        hipFuncSetAttribute((const void*)fwd<false>, hipFuncAttributeMaxDynamicSharedMemorySize, LDS_BYTES);
        hipOccupancyMaxActiveBlocksPerMultiprocessor(&per_cu, (const void*)fwd<true>, 512, LDS_BYTES);
        (void)hipGetLastError();
        if (per_cu < 1) { fprintf(stderr, "kernel_launch: occupancy query says %d workgroups per CU\n", per_cu); per_cu = 1; }
        grid = cus;
        if (grid > 256) grid = 256;
    }
    if (grid < 0) return;
    Args a{};
    for (int i = 0; i < 21; ++i) a.in[i] = (const float*)d_in[i];
    a.out = (float*)d_out; a.ws = (unsigned char*)d_ws;
    if (hipMemsetAsync((char*)d_ws + WS_BAR, 0, BAR_BYTES, stream) != hipSuccess) { fprintf(stderr, "kernel_launch: memset of the barrier words failed\n"); return; }
#if ONE_LAUNCH
    a.ph_lo = 0; a.ph_hi = N_PHASES;
    void* args[] = {&a};
    hipError_t e = hipLaunchCooperativeKernel((const void*)fwd<true>, dim3(grid), dim3(512), args, LDS_BYTES, stream);
    if (e != hipSuccess) fprintf(stderr, "cooperative launch failed: %s (grid %d)\n", hipGetErrorString(e), grid);
#else
    for (int li = 0; li < N_PHASES; ++li) { a.ph_lo = li; a.ph_hi = li + 1; hipLaunchKernelGGL(fwd<false>, dim3(grid), dim3(512), LDS_BYTES, stream, a); }
#endif
}
```

```cpp
#include <hip/hip_runtime.h>
#include <hip/hip_cooperative_groups.h>
#include <cstdio>
#include <cstdint>
namespace cg = cooperative_groups;
#ifndef ONE_LAUNCH
#define ONE_LAUNCH 1
#endif
#define DI __device__ __forceinline__
typedef float f32x2 __attribute__((ext_vector_type(2)));
typedef float f32x16 __attribute__((ext_vector_type(16)));
typedef unsigned u32x2 __attribute__((ext_vector_type(2)));
typedef short s16x4 __attribute__((ext_vector_type(4)));
typedef __bf16 bf2_t __attribute__((ext_vector_type(2)));
DI unsigned pkbf(float lo, float hi) { f32x2 v = {lo, hi}; return __builtin_bit_cast(unsigned, __builtin_convertvector(v, bf2_t)); }
DI float bf_lo(unsigned w) { return __uint_as_float(w << 16); }
DI float bf_hi(unsigned w) { return __uint_as_float(w & 0xffff0000u); }
DI float sigmoid_f(float x) { return __builtin_amdgcn_rcpf(1.0f + __expf(-x)); }
DI unsigned pk4u8(float a, float b, float c, float d) { return (unsigned)(a * 255.0f + 0.5f) | ((unsigned)(b * 255.0f + 0.5f) << 8) | ((unsigned)(c * 255.0f + 0.5f) << 16) | ((unsigned)(d * 255.0f + 0.5f) << 24); }
DI float u8f(unsigned w, int e) { return (float)((w >> (8 * e)) & 0xffu); }
namespace pg8 {
#define PG8_LAS __attribute__((address_space(3)))
typedef unsigned short bf16_t;
typedef short bf16x8 __attribute__((ext_vector_type(8)));
typedef float f32x4 __attribute__((ext_vector_type(4)));
typedef unsigned u32x4 __attribute__((ext_vector_type(4)));
constexpr int BM = 256, BK = 64, HALF = 128, HTB = HALF * BK * 2  , STAGE_BYTES = 8 * HTB, NXCD = 8, WGM = 8;

__host__ __device__ __forceinline__ int lds_byte(int r, int c) { const int st = (r >> 4) * 2 + (c >> 5), rr = r & 15, cc = c & 31, ob = rr * 64 + cc * 2; return st * 1024 + (ob ^ (((ob >> 9) & 1) << 5)); }
__host__ __device__ __forceinline__ void stage_rc(int b, int& R, int& C) { const int st = b / 1024, sb = b % 1024, swz = sb ^ (((sb >> 9) & 1) << 5); R = (st >> 1) * 16 + swz / 64; C = (st & 1) * 32 + (swz % 64) / 2; }
__host__ __device__ __forceinline__ int perm32(int rho) { const int n = rho >> 4, i = rho & 15; return 8 * (i >> 2) + 4 * n + (i & 3); }

struct Unit { int pm, pn, seg; };
struct Gemm { const bf16_t* A; const bf16_t* Bt; int K, lda, ldb, btile; };

struct StaticOrder {
    int nM, nN, nwg, G, c, wgm;
    __host__ __device__ void init(int M, int N, int G_, int c_, int wgm_ = WGM) { nM = M / BM; nN = N / BM; nwg = nM * nN; G = G_; c = c_; wgm = wgm_; }
    __host__ __device__ bool next(int i, Unit& u) const {
        const long L = (long)i * G + c; if (L >= nwg) return false;
        int wgid = (int)L; { const int q = nwg / NXCD, r = nwg % NXCD, xcd = wgid % NXCD, off = wgid / NXCD; wgid = (xcd < r ? xcd * (q + 1) : r * (q + 1) + (xcd - r) * q) + off; }
        const int nig = wgm * nN, gid = wgid / nig, fm = gid * wgm, gsz = (nM - fm) < wgm ? (nM - fm) : wgm;
        u.pm = fm + ((wgid % nig) % gsz); u.pn = (wgid % nig) / gsz; return true;
    }
    __device__ __forceinline__ int kt(const Unit&, int ntf) const { return ntf; }
    __device__ __forceinline__ size_t koff(const Unit&) const { return 0; }
    __device__ __forceinline__ void a_ready(const Unit&) const {}
    __device__ __forceinline__ void done(const Unit&) const {}
};

template <class Epi, class Sched, bool ALIGN_EPI = false, bool SP2 = false>
__device__ __forceinline__ void gemm_phase(PG8_LAS unsigned char* lds, const Gemm g, const Sched& S, const Epi& E) {
    const int tid = threadIdx.x, wid = __builtin_amdgcn_readfirstlane(tid >> 6), lane = tid & 63, wr = wid >> 2, wc = wid & 3, fr = lane & 15, fq = lane >> 4;
    const int ntf = g.K / BK;
    unsigned voffA[2], voffB[2];
#pragma unroll
    for (int i = 0; i < 2; ++i) { int R, C; stage_rc(tid * 16 + i * 8192, R, C); const int Rb = Epi::PERM ? ((R & ~31) + perm32(R & 31)) : R;
        voffA[i] = (unsigned)(R * g.lda + C) * 2u; voffB[i] = (unsigned)(Rb * g.ldb + C) * 2u; }
    const size_t kstep = (size_t)(BK * 2);
    const size_t hstepA = (size_t)HALF * g.lda * 2, hstepB = (size_t)HALF * g.ldb * 2;
    const size_t tstepA = 2 * hstepA, tstepB = (size_t)g.btile * g.ldb * 2;
    const unsigned ldsw = (unsigned)wid * 1024u;
    const int aoff = lds_byte(wr * 64 + fr, fq * 8), boff = lds_byte(wc * 32 + fr, fq * 8);
#define PG8_SA(b, h) (((b) * 2 + (h)) * HTB)
#define PG8_SB(b, h) ((4 + (b) * 2 + (h)) * HTB)
#define PG8_STAGE(bufoff, gbase, voff) do { _Pragma("unroll") for (int _i = 0; _i < 2; ++_i) \
        __builtin_amdgcn_global_load_lds((const unsigned*)((const char*)(gbase) + (voff)[_i]), (PG8_LAS unsigned*)(lds + (bufoff) + ldsw + _i * 8192), 16, 0, 0); } while (0)
#define PG8_LDA(dst, b, h) do { _Pragma("unroll") for (int m = 0; m < 4; ++m) _Pragma("unroll") for (int k = 0; k < 2; ++k) dst[m][k] = *(const PG8_LAS bf16x8*)(lds + PG8_SA(b, h) + aoff + m * 2048 + k * 1024); } while (0)
#define PG8_LDB(dst, b, h) do { _Pragma("unroll") for (int n = 0; n < 2; ++n) _Pragma("unroll") for (int k = 0; k < 2; ++k) dst[n][k] = *(const PG8_LAS bf16x8*)(lds + PG8_SB(b, h) + boff + n * 2048 + k * 1024); } while (0)
#define PG8_MMA(ai, bj, At, Bt) do { __builtin_amdgcn_s_setprio(1); _Pragma("unroll") for (int m = 0; m < 4; ++m) _Pragma("unroll") for (int n = 0; n < 2; ++n) _Pragma("unroll") for (int k = 0; k < 2; ++k) \
        acc[ai][bj][m][n] = __builtin_amdgcn_mfma_f32_16x16x32_bf16(Bt[n][k], At[m][k], acc[ai][bj][m][n], 0, 0, 0); __builtin_amdgcn_s_setprio(0); } while (0)
#define PG8_WAIT_V(n) asm volatile("s_waitcnt vmcnt(" #n ")" ::: "memory")
#define PG8_WAIT_L(n) asm volatile("s_waitcnt lgkmcnt(" #n ")" ::: "memory")
#define PG8_BAR __builtin_amdgcn_s_barrier()
#define PG8_SCHED __builtin_amdgcn_sched_barrier(0)
    Unit cur, nxt; int ui = 0;
    if (!S.next(0, cur)) return;
    f32x4 acc[2][2][4][2];
#pragma unroll
    for (int a = 0; a < 2; ++a)
#pragma unroll
        for (int b = 0; b < 2; ++b)
#pragma unroll
            for (int m = 0; m < 4; ++m)
#pragma unroll
                for (int n = 0; n < 2; ++n) acc[a][b][m][n] = (f32x4){0.f, 0.f, 0.f, 0.f};
    bf16x8 At[4][2], B0[2][2], B1[2][2];
    const char* cA = (const char*)g.A + (size_t)cur.pm * tstepA + S.koff(cur); const char* cB = (const char*)g.Bt + (size_t)cur.pn * tstepB + S.koff(cur);
    S.a_ready(cur);
    if constexpr (SP2) {
        PG8_STAGE(PG8_SB(0, 0), cB, voffB); PG8_STAGE(PG8_SB(0, 1), cB + hstepB, voffB); PG8_STAGE(PG8_SA(0, 0), cA, voffA); PG8_STAGE(PG8_SA(0, 1), cA + hstepA, voffA);
        if (wr == 1) PG8_BAR;
        PG8_WAIT_V(2); PG8_BAR;
        PG8_STAGE(PG8_SB(1, 0), cB + kstep, voffB); PG8_STAGE(PG8_SA(1, 0), cA + kstep, voffA); PG8_STAGE(PG8_SB(1, 1), cB + hstepB + kstep, voffB);
        PG8_WAIT_V(6); PG8_BAR;
    } else {
        PG8_STAGE(PG8_SB(0, 0), cB, voffB); PG8_STAGE(PG8_SA(0, 0), cA, voffA); PG8_STAGE(PG8_SB(0, 1), cB + hstepB, voffB); PG8_STAGE(PG8_SA(0, 1), cA + hstepA, voffA);
        if (wr == 1) PG8_BAR;
        PG8_WAIT_V(4); PG8_BAR;
        PG8_STAGE(PG8_SB(1, 0), cB + kstep, voffB); PG8_STAGE(PG8_SA(1, 0), cA + kstep, voffA); PG8_STAGE(PG8_SB(1, 1), cB + hstepB + kstep, voffB);
        PG8_WAIT_V(6); PG8_BAR;
    }
    for (;;) {
        const bool has_next = S.next(ui + 1, nxt);
        const char* nA = has_next ? (const char*)g.A + (size_t)nxt.pm * tstepA + S.koff(nxt) : cA; const char* nB = has_next ? (const char*)g.Bt + (size_t)nxt.pn * tstepB + S.koff(nxt) : cB;
        const int nt = S.kt(cur, ntf);
        for (int t = 0; t < nt; t += 2) {
            const bool last = (t == nt - 2);
            const char* a1 = cA + (size_t)(t + 1) * kstep;
            const char* a2 = last ? nA : cA + (size_t)(t + 2) * kstep; const char* b2 = last ? nB : cB + (size_t)(t + 2) * kstep;
            const char* a3 = a2 + kstep; const char* b3 = b2 + kstep;
            if (last && has_next) S.a_ready(nxt);
            if constexpr (SP2) {
            PG8_LDB(B0, 0, 0); PG8_LDB(B1, 0, 1); PG8_SCHED; PG8_LDA(At, 0, 0); PG8_STAGE(PG8_SA(1, 1), a1 + hstepA, voffA);
            PG8_WAIT_V(8); PG8_WAIT_L(0); PG8_BAR; PG8_MMA(0, 0, At, B0); PG8_MMA(0, 1, At, B1); PG8_BAR; PG8_SCHED;
            PG8_LDA(At, 0, 1); PG8_STAGE(PG8_SB(0, 0), b2, voffB); PG8_STAGE(PG8_SB(0, 1), b2 + hstepB, voffB); PG8_STAGE(PG8_SA(0, 0), a2, voffA);
            PG8_WAIT_V(8); PG8_WAIT_L(0); PG8_BAR; PG8_MMA(1, 0, At, B0); PG8_MMA(1, 1, At, B1); PG8_BAR; PG8_SCHED;
            PG8_LDB(B0, 1, 0); PG8_LDB(B1, 1, 1); PG8_SCHED; PG8_LDA(At, 1, 0); PG8_STAGE(PG8_SA(0, 1), a2 + hstepA, voffA);
            PG8_WAIT_V(8); PG8_WAIT_L(0); PG8_BAR; PG8_MMA(0, 0, At, B0); PG8_MMA(0, 1, At, B1); PG8_BAR; PG8_SCHED;
            PG8_LDA(At, 1, 1); PG8_STAGE(PG8_SB(1, 0), b3, voffB); PG8_STAGE(PG8_SB(1, 1), b3 + hstepB, voffB); PG8_STAGE(PG8_SA(1, 0), a3, voffA);
            PG8_WAIT_V(8); PG8_WAIT_L(0); PG8_BAR; PG8_MMA(1, 0, At, B0); PG8_MMA(1, 1, At, B1); PG8_BAR; PG8_SCHED;
            } else {
            PG8_LDB(B0, 0, 0); PG8_SCHED; PG8_LDA(At, 0, 0); PG8_STAGE(PG8_SA(1, 1), a1 + hstepA, voffA);
            PG8_WAIT_L(8); PG8_BAR; PG8_WAIT_L(0); PG8_MMA(0, 0, At, B0); PG8_BAR; PG8_SCHED;
            PG8_LDB(B1, 0, 1); PG8_STAGE(PG8_SB(0, 0), b2, voffB);
            PG8_BAR; PG8_WAIT_L(0); PG8_MMA(0, 1, At, B1); PG8_BAR;
            PG8_LDA(At, 0, 1); PG8_STAGE(PG8_SA(0, 0), a2, voffA);
            PG8_BAR; PG8_WAIT_L(0); PG8_MMA(1, 0, At, B0); PG8_BAR; PG8_SCHED;
            PG8_STAGE(PG8_SB(0, 1), b2 + hstepB, voffB);
            PG8_WAIT_V(6); PG8_BAR; PG8_MMA(1, 1, At, B1); PG8_BAR;
            PG8_LDB(B0, 1, 0); PG8_SCHED; PG8_LDA(At, 1, 0); PG8_STAGE(PG8_SA(0, 1), a2 + hstepA, voffA);
            PG8_WAIT_L(8); PG8_BAR; PG8_WAIT_L(0); PG8_MMA(0, 0, At, B0); PG8_BAR; PG8_SCHED;
            PG8_LDB(B1, 1, 1); PG8_STAGE(PG8_SB(1, 0), b3, voffB);
            PG8_BAR; PG8_WAIT_L(0); PG8_MMA(0, 1, At, B1); PG8_BAR;
            PG8_LDA(At, 1, 1); PG8_STAGE(PG8_SA(1, 0), a3, voffA);
            PG8_BAR; PG8_WAIT_L(0); PG8_MMA(1, 0, At, B0); PG8_BAR; PG8_SCHED;
            PG8_STAGE(PG8_SB(1, 1), b3 + hstepB, voffB);
            PG8_WAIT_V(6); PG8_BAR; PG8_MMA(1, 1, At, B1); PG8_BAR;
            }
        }
        if constexpr (ALIGN_EPI) { if (wr == 0) PG8_BAR; }
        bool part_ = false; if constexpr (Epi::HAS_MID) part_ = S.partial(cur);
        if constexpr (!Epi::AFTER_DRAIN) { if constexpr (Epi::HAS_MID) { if (part_) E.mid(acc, cur, wr, wc, fr, fq); else E(acc, cur, wr, wc, fr, fq); } else E(acc, cur, wr, wc, fr, fq); S.done(cur); }
        if (!has_next) break;
        if (!part_)
#pragma unroll
        for (int a = 0; a < 2; ++a)
#pragma unroll
            for (int b = 0; b < 2; ++b)
#pragma unroll
                for (int m = 0; m < 4; ++m)
#pragma unroll
                    for (int n = 0; n < 2; ++n) acc[a][b][m][n] = (f32x4){0.f, 0.f, 0.f, 0.f};
        cur = nxt; cA = nA; cB = nB; ++ui;
        if constexpr (ALIGN_EPI) { if (wr == 1) PG8_BAR; }
    }
    PG8_WAIT_V(0);
    if constexpr (!ALIGN_EPI) { if (wr == 0) PG8_BAR; }
    PG8_BAR;
    if constexpr (Epi::AFTER_DRAIN) { E.fused(acc, cur, wr, wc, fr, fq, lds, wid, lane); S.done(cur); }
#undef PG8_SA
#undef PG8_SB
#undef PG8_STAGE
#undef PG8_LDA
#undef PG8_LDB
#undef PG8_MMA
#undef PG8_WAIT_V
#undef PG8_WAIT_L
#undef PG8_BAR
#undef PG8_SCHED
}
}
namespace pg8 {
DI u32x4 pack8(f32x4 v0, f32x4 v1) { u32x4 w; w.x = pkbf(v0[0], v0[1]); w.y = pkbf(v0[2], v0[3]); w.z = pkbf(v1[0], v1[1]); w.w = pkbf(v1[2], v1[3]); return w; }
DI f32x4 sig4(f32x4 v) { f32x4 o; o[0] = sigmoid_f(v[0]); o[1] = sigmoid_f(v[1]); o[2] = sigmoid_f(v[2]); o[3] = sigmoid_f(v[3]); return o; }
DI float gelu_tanh(float x) { const float t = 1.5957691216f * (x + 0.044715f * x * x * x); return x * sigmoid_f(t); }
DI f32x4 gelu4(f32x4 v) { f32x4 o; o[0] = gelu_tanh(v[0]); o[1] = gelu_tanh(v[1]); o[2] = gelu_tanh(v[2]); o[3] = gelu_tanh(v[3]); return o; }
#define EPI_ROWS for (int ai = 0; ai < 2; ++ai) _Pragma("unroll") for (int m = 0; m < 4; ++m)

struct EpiIn {
    static constexpr bool PERM = true, AFTER_DRAIN = false, HAS_MID = false;
    bf16_t *Q, *Kb, *VT, *UC, *GATES; const float* b_gate;
    DI void operator()(const f32x4 (&acc)[2][2][4][2], const Unit& u, int wr, int wc, int fr, int fq) const {
        const int pn = u.pn, rbase = u.pm * BM + wr * 64 + fr, cb = wc * 32 + 8 * fq;
        if (pn < 4) {
            bf16_t* dst = pn < 2 ? Q : Kb; const float sc = pn < 2 ? 0.125f * 1.4426950408889634f : 1.0f;   const int c0 = (pn & 1) * 256 + cb;
#pragma unroll
            EPI_ROWS { const int row = rbase + ai * HALF + m * 16;
#pragma unroll
                for (int bj = 0; bj < 2; ++bj) *(u32x4*)(dst + (size_t)row * 512 + c0 + bj * HALF) = pack8(acc[ai][bj][m][0] * sc, acc[ai][bj][m][1] * sc); }
        } else if (pn < 6) {
#pragma unroll
            EPI_ROWS { const int row = rbase + ai * HALF + m * 16, b = row >> 12, s = row & 4095;
#pragma unroll
                for (int bj = 0; bj < 2; ++bj) { const int cv = (pn - 4) * 256 + bj * HALF + cb, h = cv >> 6, d = cv & 63;
                    bf16_t* p = VT + ((size_t)((b * 8 + h) * 64 + d)) * 4096 + s; const u32x4 w = pack8(acc[ai][bj][m][0] * 1.0f, acc[ai][bj][m][1] * 1.0f);
                    p[0] = (bf16_t)(w.x & 0xffffu); p[4096] = (bf16_t)(w.x >> 16); p[2 * 4096] = (bf16_t)(w.y & 0xffffu); p[3 * 4096] = (bf16_t)(w.y >> 16);
                    p[4 * 4096] = (bf16_t)(w.z & 0xffffu); p[5 * 4096] = (bf16_t)(w.z >> 16); p[6 * 4096] = (bf16_t)(w.w & 0xffffu); p[7 * 4096] = (bf16_t)(w.w >> 16); } }
        } else if (pn < 8) {
#pragma unroll
            EPI_ROWS { const int row = rbase + ai * HALF + m * 16, bc = row >> 6, j = row & 63;
#pragma unroll
                for (int bj = 0; bj < 2; ++bj) { const int cu = (pn - 6) * 256 + bj * HALF + cb, g = cu >> 4, hh = cu & 15;
                    *(u32x4*)(UC + ((size_t)(g * 1024 + bc)) * 1152 + 128 + j * 16 + hh) = pack8(acc[ai][bj][m][0] * 1.0f, acc[ai][bj][m][1] * 1.0f); } }
        } else {
#pragma unroll
            for (int bj = 0; bj < 2; ++bj) { const int cgt = (pn - 8) * 256 + bj * HALF + cb; const f32x4 b0 = *(const f32x4*)(b_gate + cgt), b1 = *(const f32x4*)(b_gate + cgt + 4);
#pragma unroll
                EPI_ROWS { const int row = rbase + ai * HALF + m * 16;
                    const f32x4 s0 = sig4(acc[ai][bj][m][0] + b0), s1 = sig4(acc[ai][bj][m][1] + b1);
                    *(u32x2*)((unsigned char*)GATES + (size_t)row * 2048 + cgt) = (u32x2){pk4u8(s0[0], s0[1], s0[2], s0[3]), pk4u8(s1[0], s1[1], s1[2], s1[3])}; } }
        }
    }
};
struct EpiSend {
    static constexpr bool PERM = true, AFTER_DRAIN = false, HAS_MID = false;
    float* SEND;
    DI void operator()(const f32x4 (&acc)[2][2][4][2], const Unit& u, int wr, int wc, int fr, int fq) const {
        const int g = u.pm >> 2, rbase = (u.pm & 3) * BM + wr * 64 + fr, c = wc * 32 + 8 * fq;
#pragma unroll
        EPI_ROWS { const int bc = rbase + ai * HALF + m * 16; float* p = SEND + ((size_t)bc * 32 + g) * 128 + c; *(f32x4*)p = acc[ai][0][m][0]; *(f32x4*)(p + 4) = acc[ai][0][m][1]; }
    }
};
struct EpiSsmOut {
    static constexpr bool PERM = true, AFTER_DRAIN = false, HAS_MID = false;
    bf16_t* YS;
    DI void operator()(const f32x4 (&acc)[2][2][4][2], const Unit& u, int wr, int wc, int fr, int fq) const {
        const int g = u.pm >> 2, rbase = (u.pm & 3) * BM + wr * 64 + fr, cb = (u.pn & 3) * BM + wc * 32 + 8 * fq;
#pragma unroll
        EPI_ROWS { const int bc = rbase + ai * HALF + m * 16;
#pragma unroll
            for (int bj = 0; bj < 2; ++bj) { const int n = cb + bj * HALF, i = n >> 4, h0 = n & 15;
                *(u32x4*)(YS + ((size_t)bc * 64 + i) * 512 + g * 16 + h0) = pack8(gelu4(acc[ai][bj][m][0]), gelu4(acc[ai][bj][m][1])); } }
    }
};
struct EpiGlu {
    static constexpr bool PERM = true, AFTER_DRAIN = false, HAS_MID = false;
    bf16_t* GLU;
    DI void operator()(const f32x4 (&acc)[2][2][4][2], const Unit& u, int wr, int wc, int fr, int fq) const {
        const int rbase = u.pm * BM + wr * 64 + fr, col = u.pn * HALF + wc * 32 + 8 * fq;
#pragma unroll
        EPI_ROWS { const int row = rbase + ai * HALF + m * 16;
            *(u32x4*)(GLU + (size_t)row * 1024 + 512 + col) = pack8(acc[ai][0][m][0] * sig4(acc[ai][1][m][0]), acc[ai][0][m][1] * sig4(acc[ai][1][m][1])); }
    }
};
struct EpiMix {
    static constexpr bool PERM = true, AFTER_DRAIN = false, HAS_MID = true;
    const bf16_t* GATES; bf16_t* MIXED;
    DI void mid(f32x4 (&acc)[2][2][4][2], const Unit& u, int wr, int wc, int fr, int fq) const {
        const unsigned char* gp = (const unsigned char*)GATES + (size_t)(u.pm * BM + wr * 64 + fr) * 2048 + u.pn * BM + wc * 32 + 8 * fq;
#pragma unroll
        EPI_ROWS {
#pragma unroll
            for (int bj = 0; bj < 2; ++bj) { const unsigned char* q = gp + (size_t)(ai * HALF + m * 16) * 2048 + bj * HALF; const u32x2 ga = *(const u32x2*)q, gb = *(const u32x2*)(q + 1024);
                f32x4 r0, r1;
#pragma unroll
                for (int e = 0; e < 4; ++e) { r0[e] = u8f(ga.x, e) * __builtin_amdgcn_rcpf(fmaxf(u8f(gb.x, e), 1e-18f)); r1[e] = u8f(ga.y, e) * __builtin_amdgcn_rcpf(fmaxf(u8f(gb.y, e), 1e-18f)); }
                acc[ai][bj][m][0] *= r0; acc[ai][bj][m][1] *= r1; }
            asm volatile("" ::: "memory"); }
    }
    DI void operator()(const f32x4 (&acc)[2][2][4][2], const Unit& u, int wr, int wc, int fr, int fq) const {
        const int rbase = u.pm * BM + wr * 64 + fr, cb = u.pn * BM + wc * 32 + 8 * fq;
#pragma unroll
        EPI_ROWS { const int row = rbase + ai * HALF + m * 16;
#pragma unroll
            for (int bj = 0; bj < 2; ++bj) { const int c = cb + bj * HALF; const u32x2 gb = *(const u32x2*)((const unsigned char*)GATES + (size_t)row * 2048 + 1024 + c);
                f32x4 b0, b1;
#pragma unroll
                for (int e = 0; e < 4; ++e) { b0[e] = fmaxf(u8f(gb.x, e), 1e-18f) * (1.0f / 255.0f); b1[e] = fmaxf(u8f(gb.y, e), 1e-18f) * (1.0f / 255.0f); }
                *(u32x4*)(MIXED + (size_t)row * 1024 + c) = pack8(acc[ai][bj][m][0] * b0, acc[ai][bj][m][1] * b1); } }
    }
};
template <bool BASE_BF16> struct EpiResid {
    static constexpr bool PERM = true, AFTER_DRAIN = false, HAS_MID = false;
    const float* basef; const bf16_t* baseb; bf16_t* HB; float* rowss;
    DI void operator()(const f32x4 (&acc)[2][2][4][2], const Unit& u, int wr, int wc, int fr, int fq) const {
        const int rbase = u.pm * BM + wr * 64 + fr, cb = u.pn * BM + wc * 32 + 8 * fq;
#pragma unroll
        EPI_ROWS { const int row = rbase + ai * HALF + m * 16; float ss = 0.f;
#pragma unroll
            for (int bj = 0; bj < 2; ++bj) { const size_t off = (size_t)row * 1024 + cb + bj * HALF; f32x4 b0, b1;
                if (BASE_BF16) { const u32x4 bw = *(const u32x4*)(baseb + off); b0 = (f32x4){bf_lo(bw.x), bf_hi(bw.x), bf_lo(bw.y), bf_hi(bw.y)}; b1 = (f32x4){bf_lo(bw.z), bf_hi(bw.z), bf_lo(bw.w), bf_hi(bw.w)}; }
                else { b0 = *(const f32x4*)(basef + off); b1 = *(const f32x4*)(basef + off + 4); }
                const f32x4 h0 = b0 + acc[ai][bj][m][0], h1 = b1 + acc[ai][bj][m][1];
                *(u32x4*)(HB + off) = pack8(h0, h1);
                ss += (h0[0] * h0[0] + h0[1] * h0[1]) + (h0[2] * h0[2] + h0[3] * h0[3]) + (h1[0] * h1[0] + h1[1] * h1[1]) + (h1[2] * h1[2] + h1[3] * h1[3]); }
            ss += __shfl_xor(ss, 16); ss += __shfl_xor(ss, 32);
            if (fq == 0) unsafeAtomicAdd(rowss + row, ss); }
    }
};
struct EpiFF1 {
    static constexpr bool PERM = true, AFTER_DRAIN = false, HAS_MID = false;
    const float* rowss; bf16_t* HID;
    DI void operator()(const f32x4 (&acc)[2][2][4][2], const Unit& u, int wr, int wc, int fr, int fq) const {
        const int rbase = u.pm * BM + wr * 64 + fr, cb = u.pn * BM + wc * 32 + 8 * fq;
#pragma unroll
        EPI_ROWS { const int row = rbase + ai * HALF + m * 16; const float rs = __builtin_amdgcn_rsqf(rowss[row] * (1.0f / 1024.0f) + 1e-6f);
#pragma unroll
            for (int bj = 0; bj < 2; ++bj) { f32x4 t0 = acc[ai][bj][m][0] * rs, t1 = acc[ai][bj][m][1] * rs;
                t0 = __builtin_elementwise_max(t0, (f32x4){0.f, 0.f, 0.f, 0.f}); t1 = __builtin_elementwise_max(t1, (f32x4){0.f, 0.f, 0.f, 0.f});
                *(u32x4*)(HID + (size_t)row * 4096 + cb + bj * HALF) = pack8(t0 * t0, t1 * t1); } }
    }
};
struct EndOrder {
    int G, c;
    DI bool next(int i, Unit& u) const { if (i > 0 || c >= 128 || G != 256) { const int L0 = i * G + c; if (G == 256 || L0 >= 128) return false; u.pm = L0; u.pn = L0 >> 2; return true; }
        const int L = (c & 7) * 16 + (c >> 3); u.pm = L; u.pn = L >> 2; return true; }
    DI int kt(const Unit&, int ntf) const { return ntf; }
    DI size_t koff(const Unit&) const { return 0; }
    DI void a_ready(const Unit&) const {}
    DI void done(const Unit&) const {}
};
struct OutOrder {
    int G, c;
    DI bool next(int i, Unit& u) const { const int P0 = (i >> 1) * G + c; if (P0 >= 256) return false; const int P = G == 256 ? (c & 7) * 32 + (c >> 3) : P0;     const int g = P >> 3, pmq = (P & 7) >> 1, a = P & 1, pnq = (i & 1) ? a : 3 - a; u.pm = g * 4 + pmq; u.pn = g * 4 + pnq; return true; }
    DI int kt(const Unit& u, int) const { return 2 + 4 * ((u.pn & 3) + 1); }
    DI size_t koff(const Unit&) const { return 0; }
    DI void a_ready(const Unit&) const {}
    DI void done(const Unit&) const {}
};
struct MixOrder {
    StaticOrder B;
    DI bool next(int i, Unit& u) const { if (!B.next(i >> 1, u)) return false; u.seg = i & 1; return true; }
    DI int kt(const Unit&, int) const { return 8; }
    DI size_t koff(const Unit& u) const { return (size_t)u.seg * 1024; }
    DI bool partial(const Unit& u) const { return u.seg == 0; }
    DI void a_ready(const Unit&) const {}
    DI void done(const Unit&) const {}
};
}
using pg8::bf16_t; using pg8::bf16x8; using pg8::f32x4; using pg8::u32x4;
#define LAS __attribute__((address_space(3)))
constexpr int TOK = 65536, DM = 1024, SEQ = 4096, NCH = 64, NBC = 1024;
constexpr size_t MiB = 1u << 20;
constexpr size_t WS_ROWSS1 = 0, WS_ROWSS2 = 256 * 1024;
constexpr size_t WS_BAR = 512 * 1024, BAR_BYTES = 16384 + 256, WS_QCTR = WS_BAR + 14336, WS_PCNT = WS_BAR + 16384;
constexpr size_t WS_WIN = 1 * MiB, WS_WGLU = 9 * MiB, WS_WAB = 10 * MiB, WS_WOUT = 12 * MiB, WS_WFF1 = 14 * MiB, WS_WFF2 = 22 * MiB;
constexpr size_t WS_MCAT = 30 * MiB;
constexpr size_t WS_WEND = 102 * MiB;
constexpr size_t WS_SEND = 111 * MiB;
constexpr size_t WS_UC = 128 * MiB;
constexpr size_t WS_XN = 200 * MiB;
constexpr size_t WS_MIXED = 328 * MiB;
constexpr size_t WS_Q = 328 * MiB;
constexpr size_t WS_K = 392 * MiB;
constexpr size_t WS_VT = 456 * MiB;
constexpr size_t WS_GATES = 520 * MiB;
constexpr size_t WS_HB = 776 * MiB;
constexpr size_t WS_HID = 264 * MiB;
constexpr size_t WS_ATT = 904 * MiB;
constexpr size_t WS_H2B = 128 * MiB;
constexpr size_t WS_END = 968 * MiB;
constexpr int LDS_BYTES = 147456;
constexpr float LOG2E = 1.4426950408889634f;

struct Args { const float* in[21]; float* out; unsigned char* ws; int ph_lo, ph_hi; };

DI float wave_sum(float v) {
#pragma unroll
    for (int o = 1; o < 64; o <<= 1) v += __shfl_xor(v, o);
    return v;
}
DI void transpose_item(const float* W, int K, int N, bf16_t* WT, const float* sc, LAS float* scr, int k0, int n0, int sn0, int lane) {
    float wv[32];
#pragma unroll
    for (int i = 0; i < 32; ++i) wv[i] = W[(size_t)(k0 + 2 * i + (lane >> 5)) * N + sn0 + (lane & 31)];
#pragma unroll
    for (int i = 0; i < 32; ++i) { const int kk = 2 * i + (lane >> 5); float v = wv[i]; if (sc) v *= sc[k0 + kk]; scr[kk * 33 + (lane & 31)] = v; }
    asm volatile("s_waitcnt lgkmcnt(0)" ::: "memory");
    const int c = lane & 7;
#pragma unroll
    for (int j = 0; j < 4; ++j) { const int n = (lane >> 3) + 8 * j; const LAS float* s = scr + (8 * c) * 33 + n;
        u32x4 o; o.x = pkbf(s[0 * 33], s[1 * 33]); o.y = pkbf(s[2 * 33], s[3 * 33]); o.z = pkbf(s[4 * 33], s[5 * 33]); o.w = pkbf(s[6 * 33], s[7 * 33]);
        *(u32x4*)(WT + (size_t)(n0 + n) * K + k0 + 8 * c) = o; }
    asm volatile("s_waitcnt lgkmcnt(0)" ::: "memory");
}
constexpr int SL = 130;
DI void ssm_precompute(LAS unsigned char* lds, const Args& a, unsigned char* ws, int blk, int tid) {
    const int g = blk >> 2, r = blk & 3;
    LAS float* L = (LAS float*)lds; LAS float* Cc = L + 65 * SL + 2;     LAS float* Bb = Cc + 16 * SL; LAS bf16_t* KtR = (LAS bf16_t*)(Bb + 2048);
    const float *a_re = a.in[5], *a_im = a.in[6], *log_dt = a.in[7], *b_re = a.in[8], *b_im = a.in[9], *c_re = a.in[10], *c_im = a.in[11], *dsk = a.in[12];
    const double dt = exp((double)log_dt[g]);
    if (tid < 64) { const int p = tid; const double zr = (double)a_re[g * 64 + p] * dt, zi = (double)a_im[g * 64 + p] * dt;
        double s, c; sincos(zi, &s, &c); const double e = exp(zr); const double lr = e * c, li = e * s; double pr = 1.0, pi_ = 0.0;
        for (int d = 0; d < 65; ++d) { L[d * SL + p * 2] = (float)pr; L[d * SL + p * 2 + 1] = (float)pi_; const double nr = pr * lr - pi_ * li; pi_ = pr * li + pi_ * lr; pr = nr; } }
    for (int idx = tid; idx < 1024; idx += 512) { const int p = idx >> 4; const double ar = a_re[g * 64 + p], ai = a_im[g * 64 + p]; const double zr = ar * dt, zi = ai * dt;
        double s, c; sincos(zi, &s, &c); const double e = exp(zr); const double nr = e * c - 1.0, ni = e * s, den = ar * ar + ai * ai;
        const double qr = (nr * ar + ni * ai) / den, qi = (ni * ar - nr * ai) / den;
        const double br = b_re[g * 1024 + idx], bi = b_im[g * 1024 + idx];
        Bb[idx * 2] = (float)(qr * br - qi * bi); Bb[idx * 2 + 1] = (float)(qr * bi + qi * br);
        const int ch = idx >> 6, cp = idx & 63;
        Cc[ch * SL + cp * 2] = c_re[g * 1024 + idx]; Cc[ch * SL + cp * 2 + 1] = c_im[g * 1024 + idx]; }
    __syncthreads();
    {
        const int h = tid & 15, d0 = tid >> 4, d1 = d0 + 32;
        float acc0[16], acc1[16];
#pragma unroll
        for (int e = 0; e < 16; ++e) { acc0[e] = 0.f; acc1[e] = 0.f; }
        for (int p = 0; p < 64; ++p) { const f32x2 cv = *(const LAS f32x2*)(Cc + h * SL + p * 2), l0 = *(const LAS f32x2*)(L + d0 * SL + p * 2), l1 = *(const LAS f32x2*)(L + d1 * SL + p * 2);
            const float w0r = cv[0] * l0[0] - cv[1] * l0[1], w0i = cv[0] * l0[1] + cv[1] * l0[0], w1r = cv[0] * l1[0] - cv[1] * l1[1], w1i = cv[0] * l1[1] + cv[1] * l1[0];
            const LAS f32x4* bp = (const LAS f32x4*)(Bb + p * 32);
#pragma unroll
            for (int e2 = 0; e2 < 8; ++e2) { const f32x4 bb = bp[e2];
                acc0[2 * e2] += w0r * bb[0] - w0i * bb[1]; acc0[2 * e2 + 1] += w0r * bb[2] - w0i * bb[3];
                acc1[2 * e2] += w1r * bb[0] - w1i * bb[1]; acc1[2 * e2 + 1] += w1r * bb[2] - w1i * bb[3]; } }
        if (d0 == 0) {
#pragma unroll
            for (int e = 0; e < 16; ++e) if (e == h) acc0[e] += dsk[g * 16 + h]; }
        u32x4 w0a, w0b, w1a, w1b;
        w0a.x = pkbf(acc0[0], acc0[1]); w0a.y = pkbf(acc0[2], acc0[3]); w0a.z = pkbf(acc0[4], acc0[5]); w0a.w = pkbf(acc0[6], acc0[7]);
        w0b.x = pkbf(acc0[8], acc0[9]); w0b.y = pkbf(acc0[10], acc0[11]); w0b.z = pkbf(acc0[12], acc0[13]); w0b.w = pkbf(acc0[14], acc0[15]);
        w1a.x = pkbf(acc1[0], acc1[1]); w1a.y = pkbf(acc1[2], acc1[3]); w1a.z = pkbf(acc1[4], acc1[5]); w1a.w = pkbf(acc1[6], acc1[7]);
        w1b.x = pkbf(acc1[8], acc1[9]); w1b.y = pkbf(acc1[10], acc1[11]); w1b.z = pkbf(acc1[12], acc1[13]); w1b.w = pkbf(acc1[14], acc1[15]);
        LAS u32x4* k0 = (LAS u32x4*)(KtR + (h * 64 + 63 - d0) * 16); LAS u32x4* k1 = (LAS u32x4*)(KtR + (h * 64 + 63 - d1) * 16);
        k0[0] = w0a; k0[1] = w0b; k1[0] = w1a; k1[1] = w1b;
    }
    __syncthreads();
    bf16_t* Mg = (bf16_t*)(ws + WS_MCAT) + (size_t)g * 1024 * 1152;
    for (int idx = tid; idx < 256 * 128; idx += 512) { const int rl = idx >> 7, qt = idx & 127, n = r * 256 + rl, i = n >> 4, h = n & 15;
        u32x4 w = {0u, 0u, 0u, 0u};
        if ((qt >> 1) <= i) w = *(const LAS u32x4*)(KtR + (h * 64 + 63 - i) * 16 + qt * 8);
        *(u32x4*)(Mg + (size_t)n * 1152 + 128 + qt * 8) = w; }
    for (int idx = tid; idx < 256 * 64; idx += 512) { const int rl = idx >> 6, pp = idx & 63, n = r * 256 + rl, i = n >> 4, h = n & 15, p = (2 * pp) & 63; const bool im = pp >= 32;
        const f32x2 c0 = *(const LAS f32x2*)(Cc + h * SL + p * 2), c1 = *(const LAS f32x2*)(Cc + h * SL + p * 2 + 2), l0 = *(const LAS f32x2*)(L + (i + 1) * SL + p * 2), l1 = *(const LAS f32x2*)(L + (i + 1) * SL + p * 2 + 2);
        const float v0 = im ? -(c0[0] * l0[1] + c0[1] * l0[0]) : (c0[0] * l0[0] - c0[1] * l0[1]), v1 = im ? -(c1[0] * l1[1] + c1[1] * l1[0]) : (c1[0] * l1[0] - c1[1] * l1[1]);
        *(unsigned*)(Mg + (size_t)n * 1152 + 2 * pp) = pkbf(v0, v1); }
    bf16_t* Wg = (bf16_t*)(ws + WS_WEND) + (size_t)g * 128 * 1024;
    for (int idx = tid; idx < 32 * 128; idx += 512) { const int rl = idx >> 7, q = idx & 127, n = r * 32 + rl, p = n & 63, j = q >> 1, h0 = (q & 1) * 8; const bool im = n >= 64;
        const float lr = L[(63 - j) * SL + p * 2], li = L[(63 - j) * SL + p * 2 + 1]; f32x4 v0, v1;
#pragma unroll
        for (int e = 0; e < 8; ++e) { const float br = Bb[(p * 16 + h0 + e) * 2], bi = Bb[(p * 16 + h0 + e) * 2 + 1]; const float val = im ? (lr * bi + li * br) : (lr * br - li * bi); if (e < 4) v0[e] = val; else v1[e - 4] = val; }
        *(u32x4*)(Wg + (size_t)n * 1024 + q * 8) = pg8::pack8(v0, v1); }
    __syncthreads();
}
DI void prologue(LAS unsigned char* lds, const Args& a, unsigned char* ws, int blk, int G, int tid) {
    const int lane = tid & 63, wave = tid >> 6;
    float* rss = (float*)(ws + WS_ROWSS1);
    for (int i = blk * 512 + tid; i < 2 * TOK; i += G * 512) rss[i] = 0.f;
    for (int sb = blk; sb < 128; sb += G) ssm_precompute(lds, a, ws, sb, tid);
    LAS float* scr = (LAS float*)(lds + wave * 16384);
    constexpr int I_IN = 16 * 128, I_GLU = 8 * 32, I_A = 8 * 32, I_B = 8 * 32, I_OUT = 16 * 32, I_F1 = 16 * 128, I_F2 = 64 * 32;
    constexpr int NITEMS = I_IN + I_GLU + I_A + I_B + I_OUT + I_F1 + I_F2, NXN = TOK / 16;
    unsigned* qctr = (unsigned*)(ws + WS_QCTR);
    const float* x = a.in[0]; const f32x4* gm = (const f32x4*)a.in[1] + lane; bf16_t* XN = (bf16_t*)(ws + WS_XN);
    int shard_i = 0;
    for (;;) {
        const int shard = (blk + shard_i) & 7;
        int it = 0; if (lane == 0) it = (int)__hip_atomic_fetch_add(qctr + shard * 64, 1u, __ATOMIC_RELAXED, __HIP_MEMORY_SCOPE_AGENT);
        it = __builtin_amdgcn_readfirstlane(it) * 8 + shard;
        if (it >= NITEMS + NXN) { if (++shard_i == 8) break; continue; }
        if (it >= NITEMS) {
            const int m0 = (it - NITEMS) * 16;
            f32x4 gv[4];
#pragma unroll
            for (int j = 0; j < 4; ++j) gv[j] = gm[64 * j];
            for (int mb = m0; mb < m0 + 16; mb += 4) {
                f32x4 v[4][4];
#pragma unroll
                for (int r = 0; r < 4; ++r) { const f32x4* xr = (const f32x4*)(x + (size_t)(mb + r) * DM) + lane;
#pragma unroll
                    for (int j = 0; j < 4; ++j) v[r][j] = xr[64 * j]; }
#pragma unroll
                for (int r = 0; r < 4; ++r) { float s = 0.f;
#pragma unroll
                    for (int j = 0; j < 4; ++j) s += (v[r][j][0] * v[r][j][0] + v[r][j][1] * v[r][j][1]) + (v[r][j][2] * v[r][j][2] + v[r][j][3] * v[r][j][3]);
                    const float rs = 1.0f / sqrtf(wave_sum(s) * (1.0f / DM) + 1e-6f);
                    u32x2* o8 = (u32x2*)(XN + (size_t)(mb + r) * DM) + lane;
#pragma unroll
                    for (int j = 0; j < 4; ++j) { const f32x4 t = v[r][j] * rs * gv[j]; u32x2 w; w.x = pkbf(t[0], t[1]); w.y = pkbf(t[2], t[3]); o8[64 * j] = w; } } }
            continue;
        }
        int rr = it;
        if (rr < I_IN) { transpose_item(a.in[2], 1024, 4096, (bf16_t*)(ws + WS_WIN), nullptr, scr, 64 * (rr / 128), 32 * (rr % 128), 32 * (rr % 128), lane); continue; } rr -= I_IN;
        if (rr < I_GLU) { const int n0 = 32 * (rr % 32), sn0 = ((n0 & 255) >> 7) * 512 + 128 * (n0 >> 8) + (n0 & 127);
            transpose_item(a.in[13], 512, 1024, (bf16_t*)(ws + WS_WGLU), nullptr, scr, 64 * (rr / 32), n0, sn0, lane); continue; } rr -= I_GLU;
        if (rr < I_A) { transpose_item(a.in[14], 1024, 1024, (bf16_t*)(ws + WS_WAB), nullptr, scr, 64 * (rr / 32), 32 * (rr % 32), 32 * (rr % 32), lane); continue; } rr -= I_A;
        if (rr < I_B) { transpose_item(a.in[15], 1024, 1024, (bf16_t*)(ws + WS_WAB) + 512, nullptr, scr, 64 * (rr / 32), 32 * (rr % 32), 32 * (rr % 32), lane); continue; } rr -= I_B;
        if (rr < I_OUT) { transpose_item(a.in[16], 1024, 1024, (bf16_t*)(ws + WS_WOUT), nullptr, scr, 64 * (rr / 32), 32 * (rr % 32), 32 * (rr % 32), lane); continue; } rr -= I_OUT;
        if (rr < I_F1) { transpose_item(a.in[18], 1024, 4096, (bf16_t*)(ws + WS_WFF1), a.in[17], scr, 64 * (rr / 128), 32 * (rr % 128), 32 * (rr % 128), lane); continue; } rr -= I_F1;
        transpose_item(a.in[19], 4096, 1024, (bf16_t*)(ws + WS_WFF2), nullptr, scr, 64 * (rr / 32), 32 * (rr % 32), 32 * (rr % 32), lane);
    }
    __syncthreads();
}
#define MFMA32(a, b, c) __builtin_amdgcn_mfma_f32_32x32x16_bf16((a), (b), (c), 0, 0, 0)
DI int crow(int reg, int hh) { return (reg & 3) + 8 * (reg >> 2) + 4 * hh; }
constexpr int AT_KROW = 144, AT_VROW = 136, AT_KBUF = 64 * AT_KROW, AT_VBUF = 64 * AT_VROW, AT_SEL = AT_KBUF + AT_VBUF, AT_PAR = 2 * AT_SEL, AT_BIAS = 2 * AT_PAR, AT_UQ = AT_BIAS + 2048, AT_TILES = 77824;
DI float max16(const f32x16& S) { float m = fmaxf(S[0], S[1]);
#pragma unroll
    for (int e = 2; e < 16; e += 2) m = fmaxf(fmaxf(m, S[e]), S[e + 1]);
    return m; }
DI float exp_sum16(f32x16& S) { f32x2 a = {0.f, 0.f};
#pragma unroll
    for (int e = 0; e < 16; e += 2) { S[e] = __builtin_amdgcn_exp2f(S[e]); S[e + 1] = __builtin_amdgcn_exp2f(S[e + 1]); a += (f32x2){S[e], S[e + 1]}; }
    return a[0] + a[1]; }
DI bf16x8 pack_half(const f32x16& S, int s2) { u32x4 pw; pw.x = pkbf(S[8 * s2], S[8 * s2 + 1]); pw.y = pkbf(S[8 * s2 + 2], S[8 * s2 + 3]); pw.z = pkbf(S[8 * s2 + 4], S[8 * s2 + 5]); pw.w = pkbf(S[8 * s2 + 6], S[8 * s2 + 7]); return __builtin_bit_cast(bf16x8, pw); }
DI void attn_phase(LAS unsigned char* lds, const bf16_t* Q, bf16_t* ATT, const bf16_t* Kb, const bf16_t* VT, const float* rel_bias, unsigned* actr, int tid) {
    const int wave = tid >> 6, lane = tid & 63, c32 = lane & 31, hh = lane >> 5, sel = wave >> 2;
    LAS float* bt = (LAS float*)(lds + AT_BIAS); volatile LAS int* uq = (volatile LAS int*)(lds + AT_UQ);
    const int ssel = tid >> 8, srow = (tid & 255) >> 3, spc = tid & 7;
    __syncthreads();
    if (tid == 0) uq[0] = (int)__hip_atomic_fetch_add(actr, 1u, __ATOMIC_RELAXED, __HIP_MEMORY_SCOPE_AGENT);
    __syncthreads();
    int cur = uq[0];
    while (cur < 1024) {
        int nxt_ticket = 0;
        if (tid == 0) nxt_ticket = (int)__hip_atomic_fetch_add(actr, 1u, __ATOMIC_RELAXED, __HIP_MEMORY_SCOPE_AGENT);
        const int rank = cur >> 6, bp = (cur & 63) >> 3, h = cur & 7, gidx = rank < 14 ? rank + 2 : 15 - rank, n0 = gidx * 4;
        if (tid < 257) bt[tid] = rel_bias[h * 257 + tid] * LOG2E;
        __syncthreads();
        {
            LAS float* BT = (LAS float*)(lds + AT_TILES);
            for (int idx = tid; idx < 7 * 1024; idx += 512) { const int t = idx >> 10, q = (idx >> 8) & 3, ln = (idx >> 2) & 63, r = idx & 3;
                int id = 32 * t - 32 + (ln & 31) - crow(4 * q + r, ln >> 5) + 128; id = id < 0 ? 0 : (id > 256 ? 256 : id); BT[idx] = bt[id]; }
        }
        const int bw = bp + 8 * sel, bs = bp + 8 * ssel, n = n0 + (wave & 3);
        const bf16_t* kg = Kb + ((size_t)bs * SEQ + srow) * 512 + h * 64 + spc * 8;
        const bf16_t* vg = VT + ((size_t)((bs * 8 + h) * 64 + srow)) * 4096 + spc * 8;
        const int kc_lo = n0 >= 8 ? n0 - 8 : 0, kc_hi = n0 + 3;
        const size_t tok0 = (size_t)bw * SEQ + n * 64 + c32;
        bf16x8 qf0[4], qf1[4];
#pragma unroll
        for (int s = 0; s < 4; ++s) { qf0[s] = *(const bf16x8*)(Q + tok0 * 512 + h * 64 + 32 * hh + 8 * s); qf1[s] = *(const bf16x8*)(Q + (tok0 + 32) * 512 + h * 64 + 32 * hh + 8 * s); }
        f32x16 O00, O01, O10, O11;
#pragma unroll
        for (int e = 0; e < 16; ++e) { O00[e] = 0.f; O01[e] = 0.f; O10[e] = 0.f; O11[e] = 0.f; }
        float mref0 = 0.f, mref1 = 0.f, lsum0 = 0.f, lsum1 = 0.f; bool fresh = true;
        u32x4 k0r = *(const u32x4*)(kg + (size_t)kc_lo * 64 * 512), k1r = *(const u32x4*)(kg + (size_t)kc_lo * 64 * 512 + 32 * 512), v0r = *(const u32x4*)(vg + kc_lo * 64), v1r = *(const u32x4*)(vg + kc_lo * 64 + 32 * 4096);
        for (int kc = kc_lo; kc <= kc_hi; ++kc) {
            LAS unsigned char* base = lds + ((kc - kc_lo) & 1) * AT_PAR;
            { LAS unsigned char* kw = base + ssel * AT_SEL; LAS unsigned char* vw = kw + AT_KBUF;
              *(LAS u32x4*)(kw + srow * AT_KROW + spc * 16) = k0r; *(LAS u32x4*)(kw + (srow + 32) * AT_KROW + spc * 16) = k1r;
              *(LAS u32x2*)(vw + srow * AT_VROW + spc * 16) = (u32x2){v0r.x, v0r.y}; *(LAS u32x2*)(vw + srow * AT_VROW + spc * 16 + 8) = (u32x2){v0r.z, v0r.w};
              *(LAS u32x2*)(vw + (srow + 32) * AT_VROW + spc * 16) = (u32x2){v1r.x, v1r.y}; *(LAS u32x2*)(vw + (srow + 32) * AT_VROW + spc * 16 + 8) = (u32x2){v1r.z, v1r.w}; }
            __syncthreads();
            if (kc < kc_hi) { const size_t ko = (size_t)(kc + 1) * 64 * 512; k0r = *(const u32x4*)(kg + ko); k1r = *(const u32x4*)(kg + ko + 32 * 512); v0r = *(const u32x4*)(vg + (kc + 1) * 64); v1r = *(const u32x4*)(vg + (kc + 1) * 64 + 32 * 4096); }
            const int delta = n - kc;
            if (delta >= 0 && delta <= 8) {
                const LAS unsigned char* kb_ = base + sel * AT_SEL; const LAS unsigned char* vb_ = kb_ + AT_KBUF;
#pragma unroll
                for (int kt = 0; kt < 2; ++kt) {
                    f32x16 S0, S1;
                    if (delta >= 3) { const float cf = bt[256], c0 = cf - mref0, c1 = cf - mref1;
#pragma unroll
                        for (int e = 0; e < 16; ++e) { S0[e] = c0; S1[e] = c1; }
                    } else { const LAS f32x4* t0p = (const LAS f32x4*)(lds + AT_TILES) + (2 * delta - kt + 1) * 256 + lane; const LAS f32x4* t1p = t0p + 256;
#pragma unroll
                        for (int q = 0; q < 4; ++q) { const f32x4 ta = t0p[q * 64], tb = t1p[q * 64];
#pragma unroll
                            for (int r = 0; r < 4; ++r) { S0[4 * q + r] = ta[r] - mref0; S1[4 * q + r] = tb[r] - mref1; } }
                    }
                    const LAS unsigned char* kp = kb_ + (32 * kt + c32) * AT_KROW + 64 * hh;
#pragma unroll
                    for (int s = 0; s < 4; ++s) { const bf16x8 kf = *(const LAS bf16x8*)(kp + 16 * s); S0 = MFMA32(kf, qf0[s], S0); S1 = MFMA32(kf, qf1[s], S1); }
                    float cm0 = max16(S0), cm1 = max16(S1);
                    cm0 = fmaxf(cm0, __shfl_xor(cm0, 32)); cm1 = fmaxf(cm1, __shfl_xor(cm1, 32));
                    if (fresh || __any(fmaxf(cm0, cm1) > 20.0f)) {
                        const float d0 = (fresh || cm0 > 20.0f) ? cm0 : 0.f, d1 = (fresh || cm1 > 20.0f) ? cm1 : 0.f;
                        const float s0 = fresh ? 1.0f : __builtin_amdgcn_exp2f(-d0), s1 = fresh ? 1.0f : __builtin_amdgcn_exp2f(-d1);
                        mref0 += d0; mref1 += d1; lsum0 *= s0; lsum1 *= s1;
#pragma unroll
                        for (int e = 0; e < 16; ++e) { S0[e] -= d0; S1[e] -= d1; O00[e] *= s0; O10[e] *= s0; O01[e] *= s1; O11[e] *= s1; }
                        fresh = false;
                    }
                    lsum0 += exp_sum16(S0); lsum1 += exp_sum16(S1);
                    const LAS unsigned char* vp = vb_ + c32 * AT_VROW + 8 * hh + 64 * kt;
#pragma unroll
                    for (int s2 = 0; s2 < 2; ++s2) {
                        const bf16x8 p0 = pack_half(S0, s2), p1 = pack_half(S1, s2);
                        const LAS unsigned char* v0p = vp + 32 * s2;
                        const s16x4 a0 = *(const LAS s16x4*)v0p, a1 = *(const LAS s16x4*)(v0p + 16), c0 = *(const LAS s16x4*)(v0p + 32 * AT_VROW), c1 = *(const LAS s16x4*)(v0p + 32 * AT_VROW + 16);
                        const bf16x8 vf0 = {a0[0], a0[1], a0[2], a0[3], a1[0], a1[1], a1[2], a1[3]}, vf1 = {c0[0], c0[1], c0[2], c0[3], c1[0], c1[1], c1[2], c1[3]};
                        O00 = MFMA32(vf0, p0, O00); O01 = MFMA32(vf0, p1, O01); O10 = MFMA32(vf1, p0, O10); O11 = MFMA32(vf1, p1, O11);
                    }
                }
            }
        }
        lsum0 += __shfl_xor(lsum0, 32); lsum1 += __shfl_xor(lsum1, 32);
        const float inv0 = 1.0f / lsum0, inv1 = 1.0f / lsum1;
        bf16_t* op0 = ATT + tok0 * 1024 + h * 64 + 4 * hh; bf16_t* op1 = op0 + 32 * 1024;
#pragma unroll
        for (int gq = 0; gq < 4; ++gq) { u32x2 w;
            w.x = pkbf(O00[4 * gq] * inv0, O00[4 * gq + 1] * inv0); w.y = pkbf(O00[4 * gq + 2] * inv0, O00[4 * gq + 3] * inv0); *(u32x2*)(op0 + 8 * gq) = w;
            w.x = pkbf(O10[4 * gq] * inv0, O10[4 * gq + 1] * inv0); w.y = pkbf(O10[4 * gq + 2] * inv0, O10[4 * gq + 3] * inv0); *(u32x2*)(op0 + 32 + 8 * gq) = w;
            w.x = pkbf(O01[4 * gq] * inv1, O01[4 * gq + 1] * inv1); w.y = pkbf(O01[4 * gq + 2] * inv1, O01[4 * gq + 3] * inv1); *(u32x2*)(op1 + 8 * gq) = w;
            w.x = pkbf(O11[4 * gq] * inv1, O11[4 * gq + 1] * inv1); w.y = pkbf(O11[4 * gq + 2] * inv1, O11[4 * gq + 3] * inv1); *(u32x2*)(op1 + 32 + 8 * gq) = w; }
        if (tid == 0) uq[0] = nxt_ticket;
        __syncthreads();
        cur = uq[0];
    }
    __syncthreads();
}
DI void carry_scan(const Args& a, unsigned char* ws, int blk, int G, int tid) {
    const float* SEND = (const float*)(ws + WS_SEND); bf16_t* UC = (bf16_t*)(ws + WS_UC);
    if (tid < 128)
    for (int idx = blk * 128 + tid; idx < 32768; idx += G * 128) {
        const int p = idx & 63, g = (idx >> 6) & 31, b = idx >> 11;
        const float* sp = SEND + ((size_t)(b * 64) * 32 + g) * 128 + p;
        float sr[64], si[64];
#pragma unroll
        for (int ch = 0; ch < 64; ++ch) { sr[ch] = sp[(size_t)ch * 4096]; si[ch] = sp[(size_t)ch * 4096 + 64]; }
        const double dt = exp((double)a.in[7][g]); const double zr = (double)a.in[5][g * 64 + p] * dt * 64.0, zi = (double)a.in[6][g * 64 + p] * dt * 64.0;
        double s, c; sincos(zi, &s, &c); const double e = exp(zr); const float lr = (float)(e * c), li = (float)(e * s);
        float cr = 0.f, ci = 0.f;
        bf16_t* up = UC + ((size_t)(g * 1024 + b * 64)) * 1152 + p;
#pragma unroll
        for (int ch = 0; ch < 64; ++ch) { const unsigned w = pkbf(cr, ci); up[(size_t)ch * 1152] = (bf16_t)(w & 0xffffu); up[(size_t)ch * 1152 + 64] = (bf16_t)(w >> 16);
            const float nr = lr * cr - li * ci + sr[ch], ni = lr * ci + li * cr + si[ch]; cr = nr; ci = ni; }
    }
}
DI void final_norm(const Args& a, unsigned char* ws, int blk, int G, int tid) {
    const int lane = tid & 63, wave = tid >> 6, gw = blk * 8 + wave, NGW = G * 8;
    const float* rss = (const float*)(ws + WS_ROWSS2); const bf16_t* H2B = (const bf16_t*)(ws + WS_H2B);
    const f32x4* gm = (const f32x4*)a.in[20] + 2 * lane;
    f32x4 gv[2][2];
#pragma unroll
    for (int j = 0; j < 2; ++j) { gv[j][0] = gm[128 * j]; gv[j][1] = gm[128 * j + 1]; }
    for (int m = gw; m < TOK; m += 4 * NGW) {
        u32x4 w[4][2]; float rs[4];
#pragma unroll
        for (int r = 0; r < 4; ++r) { const int mm = m + r * NGW; if (mm < TOK) { const u32x4* hp = (const u32x4*)(H2B + (size_t)mm * DM) + lane; w[r][0] = hp[0]; w[r][1] = hp[64]; rs[r] = rss[mm]; } }
#pragma unroll
        for (int r = 0; r < 4; ++r) { const int mm = m + r * NGW; if (mm < TOK) { const float sc = 1.0f / sqrtf(rs[r] * (1.0f / DM) + 1e-6f); f32x4* o = (f32x4*)(a.out + (size_t)mm * DM) + 2 * lane;
#pragma unroll
            for (int j = 0; j < 2; ++j) { const u32x4 ww = w[r][j];
                o[128 * j] = (f32x4){bf_lo(ww.x), bf_hi(ww.x), bf_lo(ww.y), bf_hi(ww.y)} * sc * gv[j][0]; o[128 * j + 1] = (f32x4){bf_lo(ww.z), bf_hi(ww.z), bf_lo(ww.w), bf_hi(ww.w)} * sc * gv[j][1]; } } } }
}
#define XB_TMO      128
#define XB_XCNT(j)  (256  + 64 * (j))
#define XB_XSUB(j)  (1280 + 64 * (j))
#define XB_XGEN(j)  (2304 + 64 * (j))
#define XB_TOP      3328
#define XB_TOPGEN   3392
#define XCD_BAR_WORDS 3456
#define XB_SPIN_CAP (1u << 18)

__device__ __forceinline__ unsigned xb_ld(unsigned* p)              { return __hip_atomic_load(p, __ATOMIC_RELAXED, __HIP_MEMORY_SCOPE_AGENT); }
__device__ __forceinline__ unsigned xb_add(unsigned* p, unsigned v) { return __hip_atomic_fetch_add(p, v, __ATOMIC_RELAXED, __HIP_MEMORY_SCOPE_AGENT); }
__device__ __forceinline__ unsigned xb_xcc_id() { return (unsigned)__builtin_amdgcn_s_getreg((3 << 11) | 20) & 0xFu; }
#define XB_SPIN(cond, bar) do { unsigned _sp = 0; while (cond) { __builtin_amdgcn_s_sleep(1); \
    if ((++_sp & 255u) == 0u) { if (xb_ld(&(bar)[XB_TMO])) break; if (_sp > XB_SPIN_CAP) { atomicAdd(&(bar)[XB_TMO], 1u); break; } } } } while (0)

struct XcdBarrier {
    unsigned* bar; unsigned x;
    volatile LAS unsigned* st;
};

__device__ __forceinline__ XcdBarrier xcd_barrier_post(unsigned* bar, volatile LAS unsigned* st) {
    XcdBarrier b; b.bar = bar; b.x = xb_xcc_id(); b.st = st;
    if (threadIdx.x == 0) (void)xb_add(&bar[XB_XCNT(b.x)], 1u);
    return b;
}
__device__ __forceinline__ void xcd_barrier_complete(unsigned* bar, unsigned x, unsigned& nloc, unsigned& nx) {
    const unsigned G = gridDim.x * gridDim.y * gridDim.z;
    unsigned sum, cnt, mine, sp = 0u;
    for (;;) {
        sum = 0u; cnt = 0u; mine = 0u;
#pragma unroll
        for (unsigned j = 0; j < 16; ++j) { const unsigned c = xb_ld(&bar[XB_XCNT(j)]); sum += c; cnt += (c > 0u) ? 1u : 0u; mine = (j == x) ? c : mine; }
        if (sum == G) break;
        __builtin_amdgcn_s_sleep(1);
        if ((++sp & 255u) == 0u) { if (xb_ld(&bar[XB_TMO])) break; if (sp > XB_SPIN_CAP) { atomicAdd(&bar[XB_TMO], 1u); break; } }
    }
    nloc = mine > 0u ? mine : 1u; nx = cnt > 0u ? cnt : 1u;
}

__device__ __forceinline__ void xcd_barrier(const XcdBarrier& b) {
    asm volatile("s_waitcnt vmcnt(0)" ::: "memory");
    __syncthreads();
    if (threadIdx.x == 0) {
        unsigned* bar = b.bar;
        __builtin_amdgcn_s_waitcnt(0);
        unsigned nloc = b.st[0], nx = b.st[1];
        if (nloc == 0u) { xcd_barrier_complete(bar, b.x, nloc, nx); b.st[0] = nloc; b.st[1] = nx; }
        const unsigned old = xb_add(&bar[XB_XSUB(b.x)], 1u);
        const unsigned gen = old / nloc;
        if (old + 1u == (gen + 1u) * nloc) {
            __builtin_amdgcn_fence(__ATOMIC_RELEASE, "agent");
            asm volatile("s_waitcnt vmcnt(0)" ::: "memory");
            const unsigned og = xb_add(&bar[XB_TOP], 1u);
            const unsigned tg = og / nx;
            if (og + 1u == (tg + 1u) * nx) xb_add(&bar[XB_TOPGEN], 1u);
            else XB_SPIN(xb_ld(&bar[XB_TOPGEN]) == tg, bar);
            __builtin_amdgcn_fence(__ATOMIC_ACQUIRE, "agent");
            xb_add(&bar[XB_XGEN(b.x)], 1u);
            asm volatile("s_waitcnt vmcnt(0)" ::: "memory");
        } else {
            XB_SPIN(xb_ld(&bar[XB_XGEN(b.x)]) == gen, bar);
            __builtin_amdgcn_fence(__ATOMIC_ACQUIRE, "agent");
            asm volatile("s_waitcnt vmcnt(0)" ::: "memory");
        }
    }
    __syncthreads();
}

#ifndef WGM_P1
#define WGM_P1 5
#endif
#ifndef WGM_P8
#define WGM_P8 10
#endif
#ifndef WGM_P9
#define WGM_P9 8
#endif
#ifndef WGM_PN
#define WGM_PN 8
#endif
constexpr int N_PHASES = 11;
constexpr int LDS_BARST = 131072 + 64;
template <bool COOP> __global__ void __launch_bounds__(512, 2) fwd(Args a) {
    extern __shared__ __attribute__((aligned(16))) unsigned char lds_raw[];
    LAS unsigned char* lds = (LAS unsigned char*)lds_raw;
    const int tid = threadIdx.x, blk = blockIdx.x, G = gridDim.x; unsigned char* ws = a.ws;
    const int lo = a.ph_lo, hi = a.ph_hi;
#ifndef PROBE_PHASE
#define PROBE_PHASE -1
#endif
#define IN(k) (lo <= (k) && (k) < hi)
#define REP(k) for (int rep_ = 0; rep_ < ((k) == PROBE_PHASE ? 2 : 1); ++rep_)
#define SEAM(k) do { if constexpr (COOP) { if (IN(k) && IN((k) + 1)) xcd_barrier(bar); } } while (0)
    bf16_t *WIN = (bf16_t*)(ws + WS_WIN), *WGLU = (bf16_t*)(ws + WS_WGLU), *WAB = (bf16_t*)(ws + WS_WAB), *WOUT = (bf16_t*)(ws + WS_WOUT), *WFF1 = (bf16_t*)(ws + WS_WFF1), *WFF2 = (bf16_t*)(ws + WS_WFF2);
    bf16_t *MCAT = (bf16_t*)(ws + WS_MCAT), *WEND = (bf16_t*)(ws + WS_WEND), *UC = (bf16_t*)(ws + WS_UC), *XN = (bf16_t*)(ws + WS_XN), *AG = XN, *MIXED = (bf16_t*)(ws + WS_MIXED), *Qb = (bf16_t*)(ws + WS_Q), *Kb = (bf16_t*)(ws + WS_K), *YS = Kb;
    bf16_t *VT = (bf16_t*)(ws + WS_VT), *GATES = (bf16_t*)(ws + WS_GATES), *HB = (bf16_t*)(ws + WS_HB), *HID = (bf16_t*)(ws + WS_HID);
    float *SEND = (float*)(ws + WS_SEND), *RSS1 = (float*)(ws + WS_ROWSS1), *RSS2 = (float*)(ws + WS_ROWSS2);
    using namespace pg8;
    XcdBarrier bar; bar.bar = (unsigned*)(ws + WS_BAR); bar.x = 0; bar.st = (volatile LAS unsigned*)(lds + LDS_BARST);
    if constexpr (COOP) {
        if (tid == 0) { bar.st[0] = 0u; bar.st[1] = 0u; }
        __syncthreads();
        bar = xcd_barrier_post((unsigned*)(ws + WS_BAR), (volatile LAS unsigned*)(lds + LDS_BARST));
        if (hi > N_PHASES) cg::this_grid().sync();
    }
    if (IN(0)) REP(0) { prologue(lds, a, ws, blk, G, tid); }
    SEAM(0);
    if (IN(1)) REP(1) { Gemm g{XN, WIN, 1024, 1024, 1024, 256}; StaticOrder S; S.init(TOK, 4096, G, blk, WGM_P1); EpiIn E{Qb, Kb, VT, UC, GATES, a.in[3]};
        gemm_phase<EpiIn, StaticOrder, true, true>(lds, g, S, E); }
    SEAM(1);
    if (IN(2)) REP(2) { { Gemm g{UC + 128, WEND, 1024, 1152, 1024, 128}; EndOrder S{G, blk}; EpiSend E{SEND}; gemm_phase<EpiSend, EndOrder, true, true>(lds, g, S, E); }
        attn_phase(lds, Qb, AG, Kb, VT, a.in[4], (unsigned*)(ws + WS_PCNT), tid);
#if PROBE_PHASE == 22
        if constexpr (COOP) { xcd_barrier(bar); if (blk == 0 && tid == 0) __hip_atomic_store((unsigned*)(ws + WS_PCNT), 0u, __ATOMIC_RELAXED, __HIP_MEMORY_SCOPE_AGENT); xcd_barrier(bar);
            attn_phase(lds, Qb, AG, Kb, VT, a.in[4], (unsigned*)(ws + WS_PCNT), tid); }
#endif
        }
    SEAM(2);
    if (IN(3)) REP(3) { carry_scan(a, ws, blk, G, tid); }
    SEAM(3);
    if (IN(4)) REP(4) { Gemm g{UC, MCAT, 1152, 1152, 1152, 256}; OutOrder S{G, blk}; EpiSsmOut E{YS}; gemm_phase<EpiSsmOut, OutOrder, true, true>(lds, g, S, E); }
    SEAM(4);
    if (IN(5)) REP(5) { Gemm g{YS, WGLU, 512, 512, 512, 256}; StaticOrder S; S.init(TOK, 1024, G, blk, WGM_PN); EpiGlu E{AG}; gemm_phase<EpiGlu, StaticOrder, true, true>(lds, g, S, E); }
    SEAM(5);
    if (IN(6)) REP(6) { Gemm g{AG, WAB, 1024, 1024, 1024, 256}; MixOrder S; S.B.init(TOK, 1024, G, blk, WGM_PN); EpiMix E{GATES, MIXED}; gemm_phase<EpiMix, MixOrder, true, true>(lds, g, S, E); }
    SEAM(6);
    if (IN(7)) REP(7) { Gemm g{MIXED, WOUT, 1024, 1024, 1024, 256}; StaticOrder S; S.init(TOK, 1024, G, blk, WGM_PN); EpiResid<false> E{a.in[0], nullptr, HB, RSS1};
        gemm_phase<EpiResid<false>, StaticOrder, true, true>(lds, g, S, E); }
    SEAM(7);
    if (IN(8)) REP(8) { Gemm g{HB, WFF1, 1024, 1024, 1024, 256}; StaticOrder S; S.init(TOK, 4096, G, blk, WGM_P8); EpiFF1 E{RSS1, HID}; gemm_phase<EpiFF1, StaticOrder, true, true>(lds, g, S, E); }
    SEAM(8);
    if (IN(9)) REP(9) { Gemm g{HID, WFF2, 4096, 4096, 4096, 256}; StaticOrder S; S.init(TOK, 1024, G, blk, WGM_P9); EpiResid<true> E{nullptr, HB, (bf16_t*)(ws + WS_H2B), RSS2};
        gemm_phase<EpiResid<true>, StaticOrder, true, true>(lds, g, S, E); }
    SEAM(9);
    if (IN(10)) REP(10) { final_norm(a, ws, blk, G, tid); }
#undef IN
#undef SEAM
}
extern "C" void kernel_launch(void* const* d_in, const int* in_sizes, int n_in, void* d_out, int out_size, void* d_ws, size_t ws_size, hipStream_t stream) {
    static int grid = 0;
    if (grid == 0) {
        if (n_in != 21 || in_sizes[0] != TOK * DM || out_size != TOK * DM || ws_size < WS_END) { fprintf(stderr, "kernel_launch: unexpected shapes (n_in %d, in0 %d, out %d, ws %zu)\n", n_in, n_in > 0 ? in_sizes[0] : -1, out_size, ws_size); grid = -1; return; }
        int dev = 0, cus = 0, per_cu = 0;
        hipGetDevice(&dev); hipDeviceGetAttribute(&cus, hipDeviceAttributeMultiprocessorCount, dev);
        hipFuncSetAttribute((const void*)fwd<true>, hipFuncAttributeMaxDynamicSharedMemorySize, LDS_BYTES);
        hipFuncSetAttribute((const void*)fwd<false>, hipFuncAttributeMaxDynamicSharedMemorySize, LDS_BYTES);
        hipOccupancyMaxActiveBlocksPerMultiprocessor(&per_cu, (const void*)fwd<true>, 512, LDS_BYTES);
        (void)hipGetLastError();
        if (per_cu < 1) { fprintf(stderr, "kernel_launch: occupancy query says %d workgroups per CU\n", per_cu); per_cu = 1; }
        grid = cus;
        if (grid > 256) grid = 256;
    }
    if (grid < 0) return;
    Args a{};
    for (int i = 0; i < 21; ++i) a.in[i] = (const float*)d_in[i];
    a.out = (float*)d_out; a.ws = (unsigned char*)d_ws;
    if (hipMemsetAsync((char*)d_ws + WS_BAR, 0, BAR_BYTES, stream) != hipSuccess) { fprintf(stderr, "kernel_launch: memset of the barrier words failed\n"); return; }
#if ONE_LAUNCH
    a.ph_lo = 0; a.ph_hi = N_PHASES;
    void* args[] = {&a};
    hipError_t e = hipLaunchCooperativeKernel((const void*)fwd<true>, dim3(grid), dim3(512), args, LDS_BYTES, stream);
    if (e != hipSuccess) fprintf(stderr, "cooperative launch failed: %s (grid %d)\n", hipGetErrorString(e), grid);
#else
    for (int li = 0; li < N_PHASES; ++li) { a.ph_lo = li; a.ph_hi = li + 1; hipLaunchKernelGGL(fwd<false>, dim3(grid), dim3(512), LDS_BYTES, stream, a); }
#endif
}
```
